# Optimizing an MI355X kernel written in HIP

```python
import jax, jax.numpy as jnp
from jax import lax
import numpy as np

D_MODEL = 2048
BATCH = 2
SEQ = 8192
DEPTH = 1
DEC_BATCH = 16
DEC_SEQ = 32
PAST_LEN = 4096

CHUNK = 64
RNN_WIDTH = 1024
RNN_BLOCKS = 16
RNN_BW = RNN_WIDTH // RNN_BLOCKS
RNN_CONV_W = 4
LRU_C = 8.0
HG_HEADS = 8
HG_DK = 128
HG_DV = 128
HG_WIDTH = HG_HEADS * HG_DK
MEM_LEN = 256
XA_HEADS = 4
XA_HD = 256
XA_WIDTH = XA_HEADS * XA_HD
N_BRANCH = 3
BRANCH_WIDTH = 1024
FFN_DIM = 5632
FFN_CONV_W = 3
EPS = 1e-6

OFF_RNN = 0
OFF_HQ = OFF_RNN + RNN_WIDTH
OFF_HF = OFF_HQ + HG_WIDTH
OFF_HI = OFF_HF + HG_WIDTH
OFF_HO = OFF_HI + HG_HEADS * HG_DV
OFF_XQ = OFF_HO + HG_HEADS * HG_DV
OFF_GATE = OFF_XQ + XA_WIDTH
IN_COLS = OFF_GATE + N_BRANCH * D_MODEL

kernel_name = "hawk_hgrn2_memxattn_convffn_stream_step"

F32 = jnp.float32


def rmsnorm(x, g):
    xf = x.astype(F32)
    y = xf * lax.rsqrt(jnp.mean(xf * xf, axis=-1, keepdims=True) + EPS)
    return (y * g.astype(F32)).astype(x.dtype)


def causal_dwconv(x, prev, w, b):
    width = w.shape[0]
    L = x.shape[1]
    xp = jnp.concatenate([prev.astype(x.dtype), x], axis=1)
    y = b
    for j in range(width):
        y = y + xp[:, j:j + L] * w[j]
    return y.astype(x.dtype), xp[:, L:]


def _lin_combine(left, right):
    a1, b1 = left
    a2, b2 = right
    return a1 * a2, a2 * b1 + b2


def rg_lru(x, h0, wa, ba, wx, bx, lam):
    B, L, C = x.shape
    xf = x.astype(F32)
    xb = xf.reshape(B, L, RNN_BLOCKS, RNN_BW)
    r = jax.nn.sigmoid(jnp.einsum('blhi,hij->blhj', xb, wa.astype(F32)) + ba.astype(F32)).reshape(B, L, C)
    ig = jax.nn.sigmoid(jnp.einsum('blhi,hij->blhj', xb, wx.astype(F32)) + bx.astype(F32)).reshape(B, L, C)
    log_a = -LRU_C * r * jax.nn.softplus(-lam.astype(F32))
    a = jnp.exp(log_a)
    b = jnp.sqrt(-jnp.expm1(2.0 * log_a)) * (ig * xf)
    b = b.at[:, 0].add(a[:, 0] * h0.astype(F32))
    _, h = lax.associative_scan(_lin_combine, (a, b), axis=1)
    return h.astype(x.dtype), h[:, -1].astype(x.dtype)


def hgrn2(q, f_raw, i, S0, lb):
    B, L, _ = q.shape
    c = min(CHUNK, L)
    n = L // c
    f = lb + (1.0 - lb) * jax.nn.sigmoid(f_raw.astype(F32))
    g = jnp.log(f)
    k = 1.0 - f

    def blocks(t, d):
        return t.astype(F32).reshape(B, n, c, HG_HEADS, d).transpose(1, 0, 3, 2, 4)

    qs, ks, gs, vs = blocks(q, HG_DK), blocks(k, HG_DK), blocks(g, HG_DK), blocks(i, HG_DV)
    tri = jnp.tril(jnp.ones((c, c), dtype=bool))[:, :, None]

    def step(S, inp):
        qc, kc, vc, gc = inp
        bcum = jnp.cumsum(gc, axis=2)
        o_inter = jnp.einsum('bhtk,bhkv->bhtv', qc * jnp.exp(bcum), S)
        diff = bcum[:, :, :, None, :] - bcum[:, :, None, :, :]
        decay = jnp.where(tri, jnp.exp(jnp.minimum(diff, 0.0)), 0.0)
        A = jnp.einsum('bhtk,bhsk,bhtsk->bhts', qc, kc, decay)
        o = o_inter + jnp.einsum('bhts,bhsv->bhtv', A, vc)
        blast = bcum[:, :, -1:, :]
        S_new = jnp.exp(blast[:, :, 0])[..., None] * S + jnp.einsum(
            'bhsk,bhsv->bhkv', kc * jnp.exp(blast - bcum), vc)
        return S_new, o

    S, o = lax.scan(step, S0.astype(F32), (qs, ks, vs, gs))
    o = o.transpose(1, 0, 3, 2, 4).reshape(B, L, HG_HEADS, HG_DV)
    return o, S


def memory_kv(mem, g, w_kv):
    B, M, _ = mem.shape
    kv = rmsnorm(mem, g) @ w_kv
    k = kv[..., :XA_WIDTH].reshape(B, M, XA_HEADS, XA_HD)
    v = kv[..., XA_WIDTH:].reshape(B, M, XA_HEADS, XA_HD)
    return k, v


def mem_cross_attn(q, mk, mv):
    B, L, _ = q.shape
    qh = q.reshape(B, L, XA_HEADS, XA_HD)
    s = jnp.einsum('blhd,bmhd->bhlm', qh, mk.astype(q.dtype)).astype(F32) * (XA_HD ** -0.5)
    p = jax.nn.softmax(s, axis=-1).astype(q.dtype)
    return jnp.einsum('bhlm,bmhd->blhd', p, mv.astype(q.dtype)).reshape(B, L, XA_WIDTH)


def trunk_layer(x, mk, mv, h0, rconv0, S0, fconv0, p, lb):
    B, L, _ = x.shape
    xn = rmsnorm(x, p['pre_mix_norm'])
    z = xn @ p['w_in']
    xr, rconv1 = causal_dwconv(z[..., OFF_RNN:OFF_HQ], rconv0, p['rnn_conv_w'], p['rnn_conv_b'])
    y_a, h1 = rg_lru(xr, h0, p['lru_wa'], p['lru_ba'], p['lru_wx'], p['lru_bx'], p['lru_lambda'])
    o, S1 = hgrn2(z[..., OFF_HQ:OFF_HF], z[..., OFF_HF:OFF_HI], z[..., OFF_HI:OFF_HO], S0, lb)
    og = jax.nn.sigmoid(z[..., OFF_HO:OFF_XQ].astype(F32)).reshape(B, L, HG_HEADS, HG_DV)
    y_b = (rmsnorm(o, p['hg_norm']) * og).reshape(B, L, HG_HEADS * HG_DV).astype(x.dtype)
    y_c = mem_cross_attn(z[..., OFF_XQ:OFF_GATE], mk, mv)
    branches = (y_a, y_b, y_c)
    m = jnp.zeros((B, L, D_MODEL), F32)
    for nb in range(N_BRANCH):
        gl = z[..., OFF_GATE + nb * D_MODEL:OFF_GATE + (nb + 1) * D_MODEL] + p['b_gate'][nb]
        m = m + jax.nn.sigmoid(gl.astype(F32)) * (branches[nb] @ p['w_branch'][nb]).astype(F32)
    y = m.astype(x.dtype) @ p['w_out']
    x = x + rmsnorm(y, p['post_mix_norm'])
    hf = rmsnorm(x, p['pre_ffn_norm']) @ p['w_ffn_up']
    u, fconv1 = causal_dwconv(hf[..., :FFN_DIM], fconv0, p['ffn_conv_w'], p['ffn_conv_b'])
    act = jax.nn.gelu(u) * hf[..., FFN_DIM:]
    x = x + rmsnorm(act @ p['w_ffn_down'], p['post_ffn_norm'])
    return x, h1, rconv1, S1.astype(x.dtype), fconv1


def setup_inputs(seed: int = 0) -> dict:
    key = jax.random.key(seed)
    kit = iter(jax.random.split(key, 48))

    def nrm(shape, scale):
        return jax.random.normal(next(kit), shape, F32) * scale

    def gain(shape):
        return 1.0 + nrm(shape, 0.05)

    u = jax.random.uniform(next(kit), (DEPTH, RNN_WIDTH), F32, minval=0.9, maxval=0.999)
    s = u ** (1.0 / LRU_C)
    lam = jnp.log(s) - jnp.log1p(-s)
    return {
        "x_prompt": nrm((BATCH, SEQ, D_MODEL), 1.0),
        "x_sample": nrm((DEC_BATCH, DEC_SEQ, D_MODEL), 1.0),
        "cache_mem_k": nrm((DEPTH, DEC_BATCH, MEM_LEN, XA_HEADS, XA_HD), 1.0),
        "cache_mem_v": nrm((DEPTH, DEC_BATCH, MEM_LEN, XA_HEADS, XA_HD), 1.0),
        "state_rnn_h": nrm((DEPTH, DEC_BATCH, RNN_WIDTH), 0.5),
        "state_rnn_conv": nrm((DEPTH, DEC_BATCH, RNN_CONV_W - 1, RNN_WIDTH), 1.0),
        "state_hg": nrm((DEPTH, DEC_BATCH, HG_HEADS, HG_DK, HG_DV), 0.5),
        "state_ffn_conv": nrm((DEPTH, DEC_BATCH, FFN_CONV_W - 1, FFN_DIM), 1.0),
        "mem_prompt": nrm((BATCH, MEM_LEN, D_MODEL), 1.0),
        "pre_mix_norm": gain((DEPTH, D_MODEL)),
        "w_in": nrm((DEPTH, D_MODEL, IN_COLS), D_MODEL ** -0.5),
        "rnn_conv_w": nrm((DEPTH, RNN_CONV_W, RNN_WIDTH), RNN_CONV_W ** -0.5),
        "rnn_conv_b": nrm((DEPTH, RNN_WIDTH), 0.01),
        "lru_wa": nrm((DEPTH, RNN_BLOCKS, RNN_BW, RNN_BW), RNN_BW ** -0.5),
        "lru_ba": nrm((DEPTH, RNN_BLOCKS, RNN_BW), 0.01),
        "lru_wx": nrm((DEPTH, RNN_BLOCKS, RNN_BW, RNN_BW), RNN_BW ** -0.5),
        "lru_bx": nrm((DEPTH, RNN_BLOCKS, RNN_BW), 0.01),
        "lru_lambda": lam,
        "hg_lb": nrm((DEPTH + 1, HG_WIDTH), 0.5),
        "hg_norm": gain((DEPTH, HG_DV)),
        "mem_norm": gain((DEPTH, D_MODEL)),
        "w_mem_kv": nrm((DEPTH, D_MODEL, 2 * XA_WIDTH), D_MODEL ** -0.5),
        "w_branch": nrm((DEPTH, N_BRANCH, BRANCH_WIDTH, D_MODEL), BRANCH_WIDTH ** -0.5),
        "b_gate": nrm((DEPTH, N_BRANCH, D_MODEL), 0.01),
        "w_out": nrm((DEPTH, D_MODEL, D_MODEL), D_MODEL ** -0.5),
        "post_mix_norm": gain((DEPTH, D_MODEL)),
        "pre_ffn_norm": gain((DEPTH, D_MODEL)),
        "w_ffn_up": nrm((DEPTH, D_MODEL, 2 * FFN_DIM), D_MODEL ** -0.5),
        "ffn_conv_w": nrm((DEPTH, FFN_CONV_W, FFN_DIM), FFN_CONV_W ** -0.5),
        "ffn_conv_b": nrm((DEPTH, FFN_DIM), 0.01),
        "w_ffn_down": nrm((DEPTH, FFN_DIM, D_MODEL), FFN_DIM ** -0.5),
        "post_ffn_norm": gain((DEPTH, D_MODEL)),
    }


def reference(x_prompt, x_sample, cache_mem_k, cache_mem_v, state_rnn_h, state_rnn_conv, state_hg,
              state_ffn_conv, mem_prompt, pre_mix_norm, w_in, rnn_conv_w, rnn_conv_b, lru_wa, lru_ba,
              lru_wx, lru_bx, lru_lambda, hg_lb, hg_norm, mem_norm, w_mem_kv, w_branch, b_gate, w_out,
              post_mix_norm, pre_ffn_norm, w_ffn_up, ffn_conv_w, ffn_conv_b, w_ffn_down, post_ffn_norm):
    lb_all = jnp.cumsum(jax.nn.softmax(hg_lb.astype(F32), axis=0), axis=0)
    yp, ys = x_prompt, x_sample
    dt = x_prompt.dtype
    mk_p_l, mv_p_l, hp_l, rcp_l, sp_l, fcp_l = [], [], [], [], [], []
    hs_l, rcs_l, ss_l, fcs_l = [], [], [], []
    for l in range(DEPTH):
        p = {
            'pre_mix_norm': pre_mix_norm[l], 'w_in': w_in[l], 'rnn_conv_w': rnn_conv_w[l],
            'rnn_conv_b': rnn_conv_b[l], 'lru_wa': lru_wa[l], 'lru_ba': lru_ba[l], 'lru_wx': lru_wx[l],
            'lru_bx': lru_bx[l], 'lru_lambda': lru_lambda[l], 'hg_norm': hg_norm[l],
            'w_branch': w_branch[l], 'b_gate': b_gate[l], 'w_out': w_out[l],
            'post_mix_norm': post_mix_norm[l], 'pre_ffn_norm': pre_ffn_norm[l], 'w_ffn_up': w_ffn_up[l],
            'ffn_conv_w': ffn_conv_w[l], 'ffn_conv_b': ffn_conv_b[l], 'w_ffn_down': w_ffn_down[l],
            'post_ffn_norm': post_ffn_norm[l],
        }
        lb = lb_all[l]
        mk_p, mv_p = memory_kv(mem_prompt, mem_norm[l], w_mem_kv[l])
        B = yp.shape[0]
        yp, h_p, rc_p, s_p, fc_p = trunk_layer(
            yp, mk_p, mv_p, jnp.zeros((B, RNN_WIDTH), dt), jnp.zeros((B, RNN_CONV_W - 1, RNN_WIDTH), dt),
            jnp.zeros((B, HG_HEADS, HG_DK, HG_DV), dt), jnp.zeros((B, FFN_CONV_W - 1, FFN_DIM), dt), p, lb)
        ys, h_s, rc_s, s_s, fc_s = trunk_layer(
            ys, cache_mem_k[l], cache_mem_v[l], state_rnn_h[l], state_rnn_conv[l], state_hg[l],
            state_ffn_conv[l], p, lb)
        mk_p_l.append(mk_p); mv_p_l.append(mv_p); hp_l.append(h_p); rcp_l.append(rc_p)
        sp_l.append(s_p); fcp_l.append(fc_p)
        hs_l.append(h_s); rcs_l.append(rc_s); ss_l.append(s_s); fcs_l.append(fc_s)
    mem_k_prompt = jnp.stack(mk_p_l)
    mem_v_prompt = jnp.stack(mv_p_l)
    rnn_h_prompt = jnp.stack(hp_l)
    rnn_conv_prompt = jnp.stack(rcp_l)
    hg_prompt = jnp.stack(sp_l)
    ffn_conv_prompt = jnp.stack(fcp_l)
    rnn_h_sample = jnp.stack(hs_l)
    rnn_conv_sample = jnp.stack(rcs_l)
    hg_sample = jnp.stack(ss_l)
    ffn_conv_sample = jnp.stack(fcs_l)
    return (yp, ys, mem_k_prompt, mem_v_prompt, rnn_h_prompt, rnn_conv_prompt, hg_prompt, ffn_conv_prompt,
            rnn_h_sample, rnn_conv_sample, hg_sample, ffn_conv_sample)
```

```cpp
#include <hip/hip_runtime.h>
#include <hip/hip_cooperative_groups.h>
#include <cstdio>
#include <cstdint>
namespace cg = cooperative_groups;

#ifndef MK_LAUNCHES
#define MK_LAUNCHES 1
#endif

#define LAS __attribute__((address_space(3)))
typedef unsigned short bf16_t;
typedef short bf16x8 __attribute__((ext_vector_type(8)));
typedef float f32x4 __attribute__((ext_vector_type(4)));
typedef float f32x2 __attribute__((ext_vector_type(2)));
typedef unsigned u32x4 __attribute__((ext_vector_type(4)));
typedef unsigned u32x2 __attribute__((ext_vector_type(2)));

constexpr int D = 2048, SEQ = 8192, MP = 16384, MS = 512, M = MP + MS, ZW = 1024, FF = 5632;
constexpr float EPS = 1e-6f;
constexpr size_t MiB = (size_t)1 << 20;
constexpr size_t ZB = (size_t)M * ZW * 2;
constexpr size_t WS_AGGA = 1 * MiB, WS_AGGB = 2 * MiB, WS_HIN = 3 * MiB, WS_DBUF = 4 * MiB, WS_RS = 6 * MiB, WS_SSQ = 8 * MiB, WS_WG = 11 * MiB, WS_US = 12 * MiB;
constexpr size_t WS_Z = 16 * MiB;
constexpr size_t WS_WBR = WS_Z + 12 * ZB;
constexpr size_t WS_WOUT = WS_WBR + 12 * MiB;
constexpr size_t WS_P = WS_WOUT + 8 * MiB;
constexpr size_t WS_KBP = WS_P + ZB;
constexpr size_t WS_VTP = WS_KBP + 1 * MiB;
constexpr size_t WS_KBS = WS_VTP + 1 * MiB;
constexpr size_t WS_VTS = WS_KBS + 8 * MiB;
constexpr size_t WS_WKV = WS_VTS + 8 * MiB;
constexpr size_t WS_MEMN = WS_WKV + 8 * MiB;
constexpr size_t WS_STS = WS_MEMN + 2 * MiB;
constexpr size_t WS_END = WS_STS + 4 * MiB;
constexpr size_t WS_MM = WS_Z + 2 * ZB;
constexpr size_t WS_WUP = WS_Z + 4 * ZB;
constexpr size_t WS_WDN = WS_WUP + 44 * MiB;
constexpr size_t WS_YPRE = WS_Z + 0 * ZB;
constexpr size_t WS_XF = WS_YPRE;
constexpr size_t WS_ACT = WS_Z + 6 * ZB;
constexpr size_t WS_SLAB6 = WS_P;
constexpr size_t WS_SLAB9 = WS_WUP;
constexpr size_t WS_YPRE2 = WS_Z + 2 * ZB;
constexpr size_t WS_R2 = 8 * MiB;
constexpr size_t DO_XN = 0, DO_WIN = 66 * MiB, DO_U = 0, DO_ST = 64 * MiB;
constexpr size_t O_Y = 0, O_MK = (size_t)M * D, O_MV = O_MK + 524288, O_RHP = O_MV + 524288, O_RCP = O_RHP + 2048, O_HGP = O_RCP + 6144, O_FCP = O_HGP + 262144,
                 O_RHS = O_FCP + 22528, O_RCS = O_RHS + 16384, O_HGS = O_RCS + 49152, O_FCS = O_HGS + 2097152, O_END = O_FCS + 180224;

constexpr int LDS_BYTES = 131072 + 1024;
constexpr int NPH = 11;
#define WGM_P1 4
#define WGM_P8 4

__device__ __forceinline__ unsigned f2bf(float f) { unsigned u = __builtin_bit_cast(unsigned, f); return (u + 0x7fffu + ((u >> 16) & 1u)) >> 16; }
__device__ __forceinline__ unsigned pk2(float lo, float hi) { return f2bf(lo) | (f2bf(hi) << 16); }
__device__ __forceinline__ float bf2f(unsigned b) { return __builtin_bit_cast(float, b << 16); }
__device__ __forceinline__ float bflo(unsigned w) { return __builtin_bit_cast(float, w << 16); }
__device__ __forceinline__ float bfhi(unsigned w) { return __builtin_bit_cast(float, w & 0xffff0000u); }
__device__ __forceinline__ float sigm(float x) { return __builtin_amdgcn_rcpf(1.f + __expf(-x)); }
__device__ __forceinline__ float wave_sum(float v) {
#pragma unroll
    for (int o = 1; o < 64; o <<= 1) v += __shfl_xor(v, o);
    return v;
}
__device__ __forceinline__ unsigned cvt_pk_bf16(float lo, float hi) { unsigned r; asm volatile("v_cvt_pk_bf16_f32 %0, %1, %2" : "=v"(r) : "v"(lo), "v"(hi)); return r; }
__device__ __forceinline__ u32x4 pack8(f32x4 a, f32x4 b) { u32x4 w; w.x = cvt_pk_bf16(a[0], a[1]); w.y = cvt_pk_bf16(a[2], a[3]); w.z = cvt_pk_bf16(b[0], b[1]); w.w = cvt_pk_bf16(b[2], b[3]); return w; }
__device__ __forceinline__ void unpack8(u32x4 w, f32x4& a, f32x4& b) { a = (f32x4){bflo(w.x), bfhi(w.x), bflo(w.y), bfhi(w.y)}; b = (f32x4){bflo(w.z), bfhi(w.z), bflo(w.w), bfhi(w.w)}; }

namespace pg8 {
constexpr int BM = 256, BK = 64, HALF = 128, HTB = HALF * BK * 2, STAGE_BYTES = 8 * HTB, NXCD = 8, WGM = 8;
__host__ __device__ __forceinline__ int lds_byte(int r, int c) { const int st = (r >> 4) * 2 + (c >> 5), rr = r & 15, cc = c & 31, ob = rr * 64 + cc * 2; return st * 1024 + (ob ^ (((ob >> 9) & 1) << 5)); }
__host__ __device__ __forceinline__ void stage_rc(int b, int& R, int& C) { const int st = b / 1024, sb = b % 1024, swz = sb ^ (((sb >> 9) & 1) << 5); R = (st >> 1) * 16 + swz / 64; C = (st & 1) * 32 + (swz % 64) / 2; }
__host__ __device__ __forceinline__ int perm32(int rho) { const int n = rho >> 4, i = rho & 15; return 8 * (i >> 2) + 4 * n + (i & 3); }

struct Unit { int pm, pn, aux; };
struct Order {
    int nM, nN, nwg, G, c, rep, wgm;
    __device__ void init(int nM_, int nN_, int G_, int c_, int rep_ = 1, int wgm_ = WGM) { nM = nM_; nN = nN_; nwg = nM * nN; G = G_; c = c_; rep = rep_; wgm = wgm_; }
    __device__ bool next(int i, Unit& u) const {
        const long L = (long)(i / rep) * G + c; if (L >= nwg) return false;
        int wgid = (int)L; { const int q = nwg / NXCD, r = nwg % NXCD, xcd = wgid % NXCD, off = wgid / NXCD; wgid = (xcd < r ? xcd * (q + 1) : r * (q + 1) + (xcd - r) * q) + off; }
        const int nig = wgm * nN, gid = wgid / nig, fm = gid * wgm, gsz = (nM - fm) < wgm ? (nM - fm) : wgm;
        u.pm = fm + ((wgid % nig) % gsz); u.pn = (wgid % nig) / gsz; u.aux = i % rep; return true;
    }
};

struct MergeOrder {
    int nM, nN, nwg, G, c, wgm;
    __device__ void init(int nM_, int nN_, int G_, int c_, int wgm_) { nM = nM_; nN = nN_; nwg = nM * nN; G = G_; c = c_; wgm = wgm_; }
    __device__ void tile(long L, Unit& u) const {
        int wgid = (int)L; { const int q = nwg / NXCD, r = nwg % NXCD, xcd = wgid % NXCD, off = wgid / NXCD; wgid = (xcd < r ? xcd * (q + 1) : r * (q + 1) + (xcd - r) * q) + off; }
        const int nig = wgm * nN, gid = wgid / nig, fm = gid * wgm, gsz = (nM - fm) < wgm ? (nM - fm) : wgm;
        u.pm = fm + ((wgid % nig) % gsz); u.pn = (wgid % nig) / gsz;
    }
    __device__ bool next(int i, Unit& u) const {
        if (G != 256 || nwg != 528) { const long L = (long)(i / 3) * G + c; if (L >= nwg) return false; tile(L, u); u.aux = i % 3; return true; }
        int k = i;
        if (c < 16) { if (k == 0) { tile(512 + c, u); u.aux = 0 | ((c + 1) << 2); return true; } k -= 1; }
        else if (c < 32) { if (k == 3) { tile(512 + c - 16, u); u.aux = 1 | ((c - 16 + 1) << 2); return true; } if (k > 3) k -= 1; }
        else if (c < 48) { if (k == 6) { tile(512 + c - 32, u); u.aux = 2 | ((c - 32 + 1) << 2); return true; } }
        if (k >= 6) return false;
        tile((long)(k / 3) * G + c, u); u.aux = k % 3; return true;
    }
};

template <class Epi, class Op, class Sched = Order>
__device__ __forceinline__ void gemm_phase(LAS unsigned char* lds, const Op& op, const Sched& S, const Epi& E) {
    const int tid = threadIdx.x, wid = __builtin_amdgcn_readfirstlane(tid >> 6), lane = tid & 63, wr = wid >> 2, wc = wid & 3, fr = lane & 15, fq = lane >> 4;
    const int K = op.K, nt = K / BK;
    unsigned voffA[2], voffB[2];
#pragma unroll
    for (int i = 0; i < 2; ++i) { int R, C; stage_rc(tid * 16 + i * 8192, R, C); const int Rb = Epi::PERM ? ((R & ~31) + perm32(R & 31)) : R;
        const int Ra = Op::SEG ? ((R & 15) * 8 + ((R >> 4) & 3)) : R;
        voffA[i] = (unsigned)(Ra * op.lda + C) * 2u; voffB[i] = (unsigned)(Rb * op.ldb + C) * 2u; }
    const size_t kstep = (size_t)(BK * 2);
    const size_t hstepA = op.hstepA();
    const size_t hstepB = (size_t)HALF * op.ldb * 2;
    const unsigned ldsw = (unsigned)wid * 1024u;
    const int aoff = lds_byte(wr * 64 + fr, fq * 8), boff = lds_byte(wc * 32 + fr, fq * 8);
#define PG8_SA(b, h) (((b) * 2 + (h)) * HTB)
#define PG8_SB(b, h) ((4 + (b) * 2 + (h)) * HTB)
#define PG8_STAGEB(bufoff, gbase) do { _Pragma("unroll") for (int _i = 0; _i < 2; ++_i) \
        __builtin_amdgcn_global_load_lds((const unsigned*)((const char*)(gbase) + voffB[_i]), (LAS unsigned*)(lds + (bufoff) + ldsw + _i * 8192), 16, 0, 0); } while (0)
#define PG8_STAGEA(bufoff, gbase, dlt) do { \
        __builtin_amdgcn_global_load_lds((const unsigned*)((const char*)(gbase) + voffA[0]), (LAS unsigned*)(lds + (bufoff) + ldsw), 16, 0, 0); \
        __builtin_amdgcn_global_load_lds((const unsigned*)((const char*)(gbase) + (dlt) + voffA[1]), (LAS unsigned*)(lds + (bufoff) + ldsw + 8192), 16, 0, 0); } while (0)
#define PG8_LDA(dst, b, h) do { _Pragma("unroll") for (int m = 0; m < 4; ++m) _Pragma("unroll") for (int k = 0; k < 2; ++k) dst[m][k] = *(const LAS bf16x8*)(lds + PG8_SA(b, h) + aoff + m * 2048 + k * 1024); } while (0)
#define PG8_LDB(dst, b, h) do { _Pragma("unroll") for (int n = 0; n < 2; ++n) _Pragma("unroll") for (int k = 0; k < 2; ++k) dst[n][k] = *(const LAS bf16x8*)(lds + PG8_SB(b, h) + boff + n * 2048 + k * 1024); } while (0)
#define PG8_MMA(ai, bj, At, Bt) do { __builtin_amdgcn_s_setprio(1); _Pragma("unroll") for (int m = 0; m < 4; ++m) _Pragma("unroll") for (int n = 0; n < 2; ++n) _Pragma("unroll") for (int k = 0; k < 2; ++k) \
        acc[ai][bj][m][n] = __builtin_amdgcn_mfma_f32_16x16x32_bf16(Bt[n][k], At[m][k], acc[ai][bj][m][n], 0, 0, 0); __builtin_amdgcn_s_setprio(0); } while (0)
#define PG8_WAIT_V(n) asm volatile("s_waitcnt vmcnt(" #n ")" ::: "memory")
#define PG8_WAIT_L(n) asm volatile("s_waitcnt lgkmcnt(" #n ")" ::: "memory")
#define PG8_BAR __builtin_amdgcn_s_barrier()
#define PG8_SCHED __builtin_amdgcn_sched_barrier(0)
    Unit cur, nxt; int ui = 0;
    if (!S.next(0, cur)) return;
    f32x4 acc[2][2][4][2];
#pragma unroll
    for (int a = 0; a < 2; ++a)
#pragma unroll
        for (int b = 0; b < 2; ++b)
#pragma unroll
            for (int m = 0; m < 4; ++m)
#pragma unroll
                for (int n = 0; n < 2; ++n) acc[a][b][m][n] = (f32x4){0.f, 0.f, 0.f, 0.f};
    bf16x8 At[4][2], B0[2][2], B1[2][2];
    const char* cA = op.a_base(cur, 0); const char* cB = op.b_base(cur);
    long dAc = Op::SEG ? (long)(op.a_base(cur, 1) - cA) : 0;
    PG8_STAGEB(PG8_SB(0, 0), cB); PG8_STAGEB(PG8_SB(0, 1), cB + hstepB); PG8_STAGEA(PG8_SA(0, 0), cA, dAc); PG8_STAGEA(PG8_SA(0, 1), cA + hstepA, dAc);
    if (wr == 1) PG8_BAR;
    PG8_WAIT_V(2); PG8_BAR;
    PG8_STAGEB(PG8_SB(1, 0), cB + kstep); PG8_STAGEA(PG8_SA(1, 0), cA + kstep, dAc); PG8_STAGEB(PG8_SB(1, 1), cB + hstepB + kstep);
    PG8_WAIT_V(6); PG8_BAR;
    for (;;) {
        const bool has_next = S.next(ui + 1, nxt);
        const char* nA = has_next ? op.a_base(nxt, 0) : cA; const char* nB = has_next ? op.b_base(nxt) : cB;
        const long dAn = Op::SEG ? (has_next ? (long)(op.a_base(nxt, 1) - nA) : dAc) : 0;
        for (int t = 0; t < nt; t += 2) {
            const bool last = (t == nt - 2);
            const char* a1 = cA + (size_t)(t + 1) * kstep;
            const char* a2 = last ? nA : cA + (size_t)(t + 2) * kstep; const char* b2 = last ? nB : cB + (size_t)(t + 2) * kstep;
            const long d2 = last ? dAn : dAc;
            const char* a3 = a2 + kstep; const char* b3 = b2 + kstep;
            PG8_LDB(B0, 0, 0); PG8_LDB(B1, 0, 1); PG8_SCHED; PG8_LDA(At, 0, 0); PG8_STAGEA(PG8_SA(1, 1), a1 + hstepA, dAc);
            PG8_WAIT_V(8); PG8_WAIT_L(0); PG8_BAR; PG8_MMA(0, 0, At, B0); PG8_MMA(0, 1, At, B1); PG8_BAR; PG8_SCHED;
            PG8_LDA(At, 0, 1); PG8_STAGEB(PG8_SB(0, 0), b2); PG8_STAGEB(PG8_SB(0, 1), b2 + hstepB); PG8_STAGEA(PG8_SA(0, 0), a2, d2);
            PG8_WAIT_V(8); PG8_WAIT_L(0); PG8_BAR; PG8_MMA(1, 0, At, B0); PG8_MMA(1, 1, At, B1); PG8_BAR; PG8_SCHED;
            PG8_LDB(B0, 1, 0); PG8_LDB(B1, 1, 1); PG8_SCHED; PG8_LDA(At, 1, 0); PG8_STAGEA(PG8_SA(0, 1), a2 + hstepA, d2);
            PG8_WAIT_V(8); PG8_WAIT_L(0); PG8_BAR; PG8_MMA(0, 0, At, B0); PG8_MMA(0, 1, At, B1); PG8_BAR; PG8_SCHED;
            PG8_LDA(At, 1, 1); PG8_STAGEB(PG8_SB(1, 0), b3); PG8_STAGEB(PG8_SB(1, 1), b3 + hstepB); PG8_STAGEA(PG8_SA(1, 0), a3, d2);
            PG8_WAIT_V(8); PG8_WAIT_L(0); PG8_BAR; PG8_MMA(1, 0, At, B0); PG8_MMA(1, 1, At, B1); PG8_BAR; PG8_SCHED;
        }
        if (wr == 0) PG8_BAR;
        E(acc, cur, wr, wc, fr, fq);
        if (!has_next) break;
#pragma unroll
        for (int a = 0; a < 2; ++a)
#pragma unroll
            for (int b = 0; b < 2; ++b)
#pragma unroll
                for (int m = 0; m < 4; ++m)
#pragma unroll
                    for (int n = 0; n < 2; ++n) acc[a][b][m][n] = (f32x4){0.f, 0.f, 0.f, 0.f};
        cur = nxt; cA = nA; cB = nB; dAc = dAn; ++ui;
        if (wr == 1) PG8_BAR;
    }
    PG8_WAIT_V(0);
    PG8_BAR;
#undef PG8_SA
#undef PG8_SB
#undef PG8_STAGEA
#undef PG8_STAGEB
#undef PG8_LDA
#undef PG8_LDB
#undef PG8_MMA
#undef PG8_WAIT_V
#undef PG8_WAIT_L
#undef PG8_BAR
#undef PG8_SCHED
}
}
using pg8::Unit; using pg8::Order;

struct OpPlain {
    static constexpr bool SEG = false;
    const bf16_t* A; const bf16_t* Bt; int K, lda, ldb;
    __device__ __forceinline__ const char* a_base(const Unit& u, int) const { return (const char*)(A + (size_t)u.pm * 256 * lda); }
    __device__ __forceinline__ const char* b_base(const Unit& u) const { return (const char*)(Bt + (size_t)u.pn * 256 * ldb); }
    __device__ __forceinline__ size_t hstepA() const { return (size_t)128 * lda * 2; }
};
struct OpMerge {
    static constexpr bool SEG = false;
    const bf16_t* ya; const bf16_t* yb; const bf16_t* yc; const bf16_t* Wt; int K, lda, ldb;
    __device__ __forceinline__ const char* a_base(const Unit& u, int) const { const int nb = u.aux & 3; const bf16_t* A = nb == 0 ? ya : (nb == 1 ? yb : yc); return (const char*)(A + (size_t)u.pm * 256 * 1024); }
    __device__ __forceinline__ const char* b_base(const Unit& u) const { return (const char*)(Wt + ((size_t)(u.aux & 3) * 2048 + (size_t)u.pn * 256) * 1024); }
    __device__ __forceinline__ size_t hstepA() const { return (size_t)128 * 1024 * 2; }
};
__device__ __forceinline__ void attn_decode(int id, int& row0, int& head, int& kvb, int& nvalid) {
    if (id < 256) { const int tile = id >> 2; head = id & 3; row0 = tile * 256; kvb = tile >> 5; nvalid = 256; }
    else { const int j = id - 256; head = j & 3; const int sb = j >> 2; row0 = MP + 32 * sb; kvb = 2 + sb; nvalid = 32; }
}
struct OpAttn {
    static constexpr bool SEG = false;
    const bf16_t* Abuf; const bf16_t* Bp; const bf16_t* Bs; int K, lda, ldb; int pv;
    __device__ __forceinline__ const char* a_base(const Unit& u, int) const { int row0, head, kvb, nv; attn_decode(u.pm, row0, head, kvb, nv); return (const char*)(Abuf + (size_t)row0 * 1024 + head * 256); }
    __device__ __forceinline__ const char* b_base(const Unit& u) const { int row0, head, kvb, nv; attn_decode(u.pm, row0, head, kvb, nv);
        const bf16_t* base = kvb < 2 ? Bp + (size_t)kvb * 262144 : Bs + (size_t)(kvb - 2) * 262144;
        return (const char*)(pv ? base + (size_t)head * 256 * 256 : base + head * 256); }
    __device__ __forceinline__ size_t hstepA() const { return (size_t)128 * 1024 * 2; }
};
__device__ __forceinline__ int seg_base_row(int g) { if (g < 132) { const int b = g / 66, gi = g - 66 * b; return b * SEQ + 126 * gi - 2; } return MP + 128 * (g - 132); }
struct OpUp {
    static constexpr bool SEG = true;
    const bf16_t* A; const bf16_t* Bt; int K, lda, ldb;
    __device__ __forceinline__ const char* a_base(const Unit& u, int piece) const { return (const char*)(A + (long)seg_base_row(2 * u.pm + piece) * lda); }
    __device__ __forceinline__ const char* b_base(const Unit& u) const { return (const char*)(Bt + (size_t)u.pn * 256 * ldb); }
    __device__ __forceinline__ size_t hstepA() const { return (size_t)4 * lda * 2; }
};

typedef f32x4 Acc[2][2][4][2];

struct EpiZ {
    static constexpr bool PERM = true;
    bf16_t* Z;
    __device__ __forceinline__ void operator()(const Acc& acc, const Unit& u, int wr, int wc, int fr, int fq) const {
        const int seg = u.pn >> 2, col0 = (u.pn & 3) * 256 + wc * 32 + 8 * fq; const int row0 = u.pm * 256 + wr * 64 + fr;
        bf16_t* base = Z + (size_t)seg * ((size_t)M * ZW);
#pragma unroll
        for (int ai = 0; ai < 2; ++ai)
#pragma unroll
            for (int m = 0; m < 4; ++m) { bf16_t* rowp = base + (size_t)(row0 + ai * 128 + m * 16) * ZW + col0;
#pragma unroll
                for (int bj = 0; bj < 2; ++bj) *(u32x4*)(rowp + bj * 128) = pack8(acc[ai][bj][m][0], acc[ai][bj][m][1]); }
    }
};
struct EpiKV {
    static constexpr bool PERM = true;
    float* out; bf16_t* kb;
    __device__ __forceinline__ void operator()(const Acc& acc, const Unit& u, int wr, int wc, int fr, int fq) const {
        const bool isv = u.pn >= 4; const int col0 = (u.pn & 3) * 256 + wc * 32 + 8 * fq; const int row0 = u.pm * 256 + wr * 64 + fr;
        float* ob = out + (isv ? O_MV : O_MK);
#pragma unroll
        for (int ai = 0; ai < 2; ++ai)
#pragma unroll
            for (int m = 0; m < 4; ++m) { const size_t ro = (size_t)(row0 + ai * 128 + m * 16) * 1024 + col0;
#pragma unroll
                for (int bj = 0; bj < 2; ++bj) { *(f32x4*)(ob + ro + bj * 128) = acc[ai][bj][m][0]; *(f32x4*)(ob + ro + bj * 128 + 4) = acc[ai][bj][m][1];
                    if (!isv) *(u32x4*)(kb + ro + bj * 128) = pack8(acc[ai][bj][m][0], acc[ai][bj][m][1]); } }
    }
};
struct EpiS {
    static constexpr bool PERM = true;
    bf16_t* P; float* rs;
    __device__ __forceinline__ void operator()(const Acc& acc, const Unit& u, int wr, int wc, int fr, int fq) const {
        int row0, head, kvb, nv; attn_decode(u.pm, row0, head, kvb, nv);
#pragma unroll
        for (int ai = 0; ai < 2; ++ai)
#pragma unroll
            for (int m = 0; m < 4; ++m) { const int rt = ai * 128 + wr * 64 + m * 16 + fr; float s = 0.f; u32x4 w[2];
#pragma unroll
                for (int bj = 0; bj < 2; ++bj) { f32x4 p0, p1;
#pragma unroll
                    for (int j = 0; j < 4; ++j) { p0[j] = __expf(acc[ai][bj][m][0][j] * 0.0625f); p1[j] = __expf(acc[ai][bj][m][1][j] * 0.0625f); }
                    s += (p0[0] + p0[1]) + (p0[2] + p0[3]) + (p1[0] + p1[1]) + (p1[2] + p1[3]); w[bj] = pack8(p0, p1); }
                s += __shfl_xor(s, 16); s += __shfl_xor(s, 32);
                if (rt < nv) { bf16_t* rowp = P + (size_t)(row0 + rt) * 1024 + head * 256 + wc * 32 + 8 * fq;
                    *(u32x4*)rowp = w[0]; *(u32x4*)(rowp + 128) = w[1];
                    if (fq == 0) rs[(size_t)(row0 + rt) * 16 + head * 4 + wc] = s; } }
    }
};
struct EpiPV {
    static constexpr bool PERM = true;
    bf16_t* Y; const float* rs;
    __device__ __forceinline__ void operator()(const Acc& acc, const Unit& u, int wr, int wc, int fr, int fq) const {
        int row0, head, kvb, nv; attn_decode(u.pm, row0, head, kvb, nv);
#pragma unroll
        for (int ai = 0; ai < 2; ++ai)
#pragma unroll
            for (int m = 0; m < 4; ++m) { const int rt = ai * 128 + wr * 64 + m * 16 + fr;
                if (rt < nv) { const f32x4 r4 = *(const f32x4*)(rs + (size_t)(row0 + rt) * 16 + head * 4); const float inv = 1.f / ((r4[0] + r4[1]) + (r4[2] + r4[3]));
                    bf16_t* rowp = Y + (size_t)(row0 + rt) * 1024 + head * 256 + wc * 32 + 8 * fq;
#pragma unroll
                    for (int bj = 0; bj < 2; ++bj) *(u32x4*)(rowp + bj * 128) = pack8(acc[ai][bj][m][0] * inv, acc[ai][bj][m][1] * inv); } }
    }
};
struct EpiMerge {
    static constexpr bool PERM = true;
    const bf16_t* Zg; const float* bgate; bf16_t* MM; unsigned* flags;
    __device__ __forceinline__ void operator()(const Acc& acc, const Unit& u, int wr, int wc, int fr, int fq) const {
        const int nb = u.aux & 3, xj = (u.aux >> 2) - 1;
        if (xj >= 0 && nb > 0) {
            unsigned sp = 0; while (__hip_atomic_load(flags + 64 * xj, __ATOMIC_RELAXED, __HIP_MEMORY_SCOPE_AGENT) < 8u * (unsigned)nb) { __builtin_amdgcn_s_sleep(2); if (++sp > (1u << 22)) break; }
            __builtin_amdgcn_fence(__ATOMIC_ACQUIRE, "agent"); } const bf16_t* gb = Zg + (size_t)(2 * nb + (u.pn >> 2)) * ((size_t)M * ZW);
        const int gcol = (u.pn & 3) * 256 + wc * 32 + 8 * fq, ocol = u.pn * 256 + wc * 32 + 8 * fq; const int row0 = u.pm * 256 + wr * 64 + fr;
        f32x4 bg[2][2];
#pragma unroll
        for (int bj = 0; bj < 2; ++bj) { bg[bj][0] = *(const f32x4*)(bgate + nb * 2048 + ocol + bj * 128); bg[bj][1] = *(const f32x4*)(bgate + nb * 2048 + ocol + bj * 128 + 4); }
#pragma unroll
        for (int am = 0; am < 4; ++am) { const int ai = am >> 1, mb = (am & 1) * 2;
            u32x4 gw[2][2], pw[2][2];
#pragma unroll
            for (int mm = 0; mm < 2; ++mm)
#pragma unroll
                for (int bj = 0; bj < 2; ++bj) { const size_t row = (size_t)(row0 + ai * 128 + (mb + mm) * 16);
                    gw[mm][bj] = *(const u32x4*)(gb + row * ZW + gcol + bj * 128);
                    pw[mm][bj] = nb > 0 ? *(const u32x4*)(MM + row * D + ocol + bj * 128) : (u32x4){0u, 0u, 0u, 0u}; }
#pragma unroll
            for (int mm = 0; mm < 2; ++mm)
#pragma unroll
                for (int bj = 0; bj < 2; ++bj) { const int m = mb + mm; const size_t row = (size_t)(row0 + ai * 128 + m * 16);
                    f32x4 g0, g1, p0, p1; unpack8(gw[mm][bj], g0, g1); unpack8(pw[mm][bj], p0, p1);
#pragma unroll
                    for (int j = 0; j < 4; ++j) { p0[j] += sigm(g0[j] + bg[bj][0][j]) * acc[ai][bj][m][0][j]; p1[j] += sigm(g1[j] + bg[bj][1][j]) * acc[ai][bj][m][1][j]; }
                    *(u32x4*)(MM + row * D + ocol + bj * 128) = pack8(p0, p1); }
        }
        if (xj >= 0 && nb < 2) {
            __builtin_amdgcn_fence(__ATOMIC_RELEASE, "agent"); asm volatile("s_waitcnt vmcnt(0)" ::: "memory");
            if (fr == 0 && fq == 0) __hip_atomic_fetch_add(flags + 64 * xj, 1u, __ATOMIC_RELAXED, __HIP_MEMORY_SCOPE_AGENT); }
    }
};
struct EpiPre {
    static constexpr bool PERM = true;
    bf16_t* Y;
    __device__ __forceinline__ void operator()(const Acc& acc, const Unit& u, int wr, int wc, int fr, int fq) const {
        const int ocol = u.pn * 256 + wc * 32 + 8 * fq; const int row0 = u.pm * 256 + wr * 64 + fr;
#pragma unroll
        for (int ai = 0; ai < 2; ++ai)
#pragma unroll
            for (int m = 0; m < 4; ++m) { const size_t row = (size_t)(row0 + ai * 128 + m * 16);
#pragma unroll
                for (int bj = 0; bj < 2; ++bj) *(u32x4*)(Y + row * D + ocol + bj * 128) = pack8(acc[ai][bj][m][0], acc[ai][bj][m][1]); }
    }
};
struct OpSplit {
    static constexpr bool SEG = false;
    const bf16_t* A; const bf16_t* Bt; int K, lda, ldb;
    __device__ __forceinline__ const char* a_base(const Unit& u, int) const { return (const char*)(A + (size_t)(MP + 256 * (u.pm & 1)) * lda + (size_t)(u.pm >> 1) * K); }
    __device__ __forceinline__ const char* b_base(const Unit& u) const { return (const char*)(Bt + (size_t)u.pn * 256 * ldb + (size_t)(u.pm >> 1) * K); }
    __device__ __forceinline__ size_t hstepA() const { return (size_t)128 * lda * 2; }
};
struct EpiSlab {
    static constexpr bool PERM = true;
    float* slab;
    __device__ __forceinline__ void operator()(const Acc& acc, const Unit& u, int wr, int wc, int fr, int fq) const {
        const int ocol = u.pn * 256 + wc * 32 + 8 * fq; const int row0 = (u.pm >> 1) * 512 + (u.pm & 1) * 256 + wr * 64 + fr;
#pragma unroll
        for (int ai = 0; ai < 2; ++ai)
#pragma unroll
            for (int m = 0; m < 4; ++m) { float* rp = slab + (size_t)(row0 + ai * 128 + m * 16) * D + ocol;
#pragma unroll
                for (int bj = 0; bj < 2; ++bj) { *(f32x4*)(rp + bj * 128) = acc[ai][bj][m][0]; *(f32x4*)(rp + bj * 128 + 4) = acc[ai][bj][m][1]; } }
    }
};
__device__ __forceinline__ float gelu_tanh(float x) { const float y = 1.5957691216f * (x + 0.044715f * x * x * x); return x * __builtin_amdgcn_rcpf(1.f + __expf(-y)); }
__device__ __forceinline__ f32x2 gelu_mul_pk(f32x2 c, f32x2 v) {
    const f32x2 c2 = c * c; const f32x2 t = c * (c2 * (-0.10294324f) + (-2.3022082f));
    f32x2 e; e.x = __builtin_amdgcn_exp2f(t.x); e.y = __builtin_amdgcn_exp2f(t.y);
    const f32x2 d = e + 1.0f; f32x2 r; r.x = __builtin_amdgcn_rcpf(d.x); r.y = __builtin_amdgcn_rcpf(d.y);
    return (c * v) * r;
}
struct EpiUp {
    static constexpr bool PERM = true;
    bf16_t* act; const float* cw; const float* cb; const float* st; float* out; const float* r2;
    __device__ __forceinline__ void operator()(const Acc& acc, const Unit& u, int wr, int wc, int fr, int fq) const {
        const int g = 2 * u.pm + wr; const int col = u.pn * 128 + wc * 32 + 8 * fq;
        const bool smp = g >= 132; const int b = smp ? 0 : g / 66, gi = g - 66 * b; const int s0 = 126 * gi - 2;
        f32x4 w0[2], w1[2], w2[2], bb[2];
#pragma unroll
        for (int n = 0; n < 2; ++n) { w0[n] = *(const f32x4*)(cw + col + 4 * n); w1[n] = *(const f32x4*)(cw + FF + col + 4 * n); w2[n] = *(const f32x4*)(cw + 2 * FF + col + 4 * n); bb[n] = *(const f32x4*)(cb + col + 4 * n); }
        float rr[8];
#pragma unroll
        for (int e = 0; e < 8; ++e) { const int idx = fr * 8 + e; int row = smp ? MP + 128 * (g - 132) + idx : b * SEQ + s0 + idx; row = row < 0 ? 0 : row; rr[e] = r2[row]; }
#pragma unroll
        for (int n = 0; n < 2; ++n) {
            f32x4 um2, um1;
#pragma unroll
            for (int j = 0; j < 4; ++j) { um2[j] = __shfl_up(acc[1][0][2][n][j] * rr[6], 1); um1[j] = __shfl_up(acc[1][0][3][n][j] * rr[7], 1); }
            if (smp) { if ((fr & 3) == 0) { const int sb = 4 * (g - 132) + (fr >> 2); um2 = *(const f32x4*)(st + (size_t)(sb * 2 + 0) * FF + col + 4 * n); um1 = *(const f32x4*)(st + (size_t)(sb * 2 + 1) * FF + col + 4 * n); } }
#pragma unroll
            for (int e = 0; e < 8; ++e) { const int ai = e >> 2, m = e & 3; f32x4 uu = acc[ai][0][m][n] * rr[e]; const f32x4 vv = acc[ai][1][m][n] * rr[e];
                const int idx = fr * 8 + e; bool valid; size_t row;
                if (smp) { valid = true; row = (size_t)(MP + 128 * (g - 132) + idx); }
                else { const int tm = s0 + idx; if (tm < 0) uu = (f32x4){0.f, 0.f, 0.f, 0.f}; valid = (idx >= 2) && (tm < SEQ); row = (size_t)(b * SEQ + tm); }
                f32x4 c = bb[n] + w0[n] * um2 + w1[n] * um1 + w2[n] * uu;
                const f32x2 a01 = gelu_mul_pk((f32x2){c[0], c[1]}, (f32x2){vv[0], vv[1]}), a23 = gelu_mul_pk((f32x2){c[2], c[3]}, (f32x2){vv[2], vv[3]});
                const f32x4 a = (f32x4){a01.x, a01.y, a23.x, a23.y};
                if (valid) { u32x2 w; w.x = cvt_pk_bf16(a[0], a[1]); w.y = cvt_pk_bf16(a[2], a[3]); *(u32x2*)(act + row * FF + col + 4 * n) = w;
                    if (smp) { const int tau = idx & 31; if (tau >= 30) *(f32x4*)(out + O_FCS + (size_t)((4 * (g - 132) + (idx >> 5)) * 2 + (tau - 30)) * FF + col + 4 * n) = uu; }
                    else { const int tm = s0 + idx; if (tm >= SEQ - 2) *(f32x4*)(out + O_FCP + (size_t)(b * 2 + (tm - (SEQ - 2))) * FF + col + 4 * n) = uu; } }
                um2 = um1; um1 = uu; }
        }
    }
};

struct Ctx { LAS unsigned char* lds; int tid, lane, wave, G, bid; const float* const* in; float* out; unsigned char* ws; };

__device__ __forceinline__ void transpose_item(const float* W, int ldw, bf16_t* WT, int ldt, int k0, int n0, int drow0, LAS float* scr, int lane, const float* rscale = nullptr) {
    float tv[32];
#pragma unroll
    for (int i = 0; i < 32; ++i) { const int kk = 2 * i + (lane >> 5); tv[i] = W[(size_t)(k0 + kk) * ldw + n0 + (lane & 31)]; }
    if (rscale) {
#pragma unroll
        for (int i = 0; i < 32; ++i) tv[i] *= rscale[k0 + 2 * i + (lane >> 5)]; }
#pragma unroll
    for (int i = 0; i < 32; ++i) { const int kk = 2 * i + (lane >> 5); scr[kk * 33 + (lane & 31)] = tv[i]; }
    asm volatile("s_waitcnt lgkmcnt(0)" ::: "memory");
    const int c = lane & 7;
#pragma unroll
    for (int j = 0; j < 4; ++j) { const int n = (lane >> 3) + 8 * j; const LAS float* s = scr + (8 * c) * 33 + n;
        u32x4 o; o.x = pk2(s[0 * 33], s[1 * 33]); o.y = pk2(s[2 * 33], s[3 * 33]); o.z = pk2(s[4 * 33], s[5 * 33]); o.w = pk2(s[6 * 33], s[7 * 33]);
        *(u32x4*)(WT + (size_t)(drow0 + n) * ldt + k0 + 8 * c) = o; }
    asm volatile("s_waitcnt lgkmcnt(0)" ::: "memory");
}
template <class F> __device__ __forceinline__ void transpose_job(const float* W, int K, int N, bf16_t* WT, int ldt, int r, LAS float* scr, int lane, F dmap, const float* rscale = nullptr) {
    const int nblk = N / 32, kb = r / nblk, nb = r % nblk; transpose_item(W, N, WT, ldt, 64 * kb, 32 * nb, dmap(32 * nb), scr, lane, rscale);
}
__device__ __forceinline__ const float* xrow_ptr(const Ctx& c, int m) { return m < MP ? c.in[0] + (size_t)m * D : c.in[1] + (size_t)(m - MP) * D; }
__device__ __forceinline__ void rms_row_bf16(const float* xrow, const float* g, bf16_t* orow, int lane) {
    const f32x4* xr = (const f32x4*)xrow + lane; f32x4 v[8]; float s = 0.f;
#pragma unroll
    for (int j = 0; j < 8; ++j) { v[j] = xr[64 * j]; s += (v[j][0] * v[j][0] + v[j][1] * v[j][1]) + (v[j][2] * v[j][2] + v[j][3] * v[j][3]); }
    const float rs = rsqrtf(wave_sum(s) * (1.f / D) + EPS);
    u32x2* o = (u32x2*)orow + lane;
#pragma unroll
    for (int j = 0; j < 8; ++j) { const f32x4 gg = ((const f32x4*)g)[lane + 64 * j]; u32x2 w; w.x = pk2(v[j][0] * rs * gg[0], v[j][1] * rs * gg[1]); w.y = pk2(v[j][2] * rs * gg[2], v[j][3] * rs * gg[3]); o[64 * j] = w; }
}

__device__ __forceinline__ void prep_late(const Ctx& c, int wv, int nwv) {
    LAS float* scr = (LAS float*)(c.lds + c.wave * 16384);
    constexpr int I_BR = 16 * 64, I_OUT = 32 * 64, I_VS = 4 * 32, I_HG = 2 * 4;
    constexpr int NIT = 3 * I_BR + I_OUT + 16 * I_VS + 128 * I_HG;
    for (int it = wv; it < NIT; it += nwv) {
        int r = it;
        if (r < 3 * I_BR) { const int nb = r / I_BR; transpose_job(c.in[22] + (size_t)nb * 1024 * 2048, 1024, 2048, (bf16_t*)(c.ws + WS_WBR) + (size_t)nb * 2048 * 1024, 1024, r % I_BR, scr, c.lane, [](int n0) { return n0; }); continue; } r -= 3 * I_BR;
        if (r < I_OUT) { transpose_job(c.in[24], 2048, 2048, (bf16_t*)(c.ws + WS_WOUT), 2048, r, scr, c.lane, [](int n0) { return n0; }); continue; } r -= I_OUT;
        if (r < 16 * I_VS) { const int b = r / I_VS; transpose_job(c.in[3] + (size_t)b * 262144, 256, 1024, (bf16_t*)(c.ws + WS_VTS) + (size_t)b * 262144, 256, r % I_VS, scr, c.lane, [](int n0) { return n0; }); continue; } r -= 16 * I_VS;
        { const int sq = r / I_HG; transpose_job(c.in[6] + (size_t)sq * 16384, 128, 128, (bf16_t*)(c.ws + WS_STS) + (size_t)sq * 16384, 128, r % I_HG, scr, c.lane, [](int n0) { return n0; }); }
    }
}
__device__ __forceinline__ void phase_prep(const Ctx& c) {
    LAS float* scr = (LAS float*)(c.lds + c.wave * 16384);
    const int gw = c.bid * 8 + c.wave, NGW = c.G * 8;
    bf16_t* win_t = (bf16_t*)((unsigned char*)c.out + DO_WIN);
    constexpr int I_IN = 32 * 384, I_KV = 32 * 64, I_G = 2;
    constexpr int NIT = I_IN + I_KV + 32 * I_G;
    for (int it = gw; it < NIT; it += NGW) {
        int r = it;
        if (r < I_IN) { transpose_job(c.in[10], 2048, 12288, win_t, 2048, r, scr, c.lane, [](int n0) { if (n0 >= 6144) return n0; const int seg = n0 >> 10; const int ps = seg <= 3 ? seg + 2 : seg - 4; return ps * 1024 + (n0 & 1023); }); continue; } r -= I_IN;
        if (r < I_KV) { transpose_job(c.in[21], 2048, 2048, (bf16_t*)(c.ws + WS_WKV), 2048, r, scr, c.lane, [](int n0) { return n0; }); continue; } r -= I_KV;
        { const int h = r / (2 * I_G), which = (r / I_G) & 1, rr = r % I_G;
          transpose_job(c.in[which ? 15 : 13] + (size_t)h * 4096, 64, 64, (bf16_t*)(c.ws + WS_WG) + (size_t)h * 8192 + which * 4096, 64, rr, scr, c.lane, [](int n0) { return n0; }); }
    }
    bf16_t* xn = (bf16_t*)((unsigned char*)c.out + DO_XN);
    for (int m = gw; m < M + 512; m += NGW) {
        if (m < M) rms_row_bf16(xrow_ptr(c, m), c.in[9], xn + (size_t)m * D, c.lane);
        else rms_row_bf16(c.in[8] + (size_t)(m - M) * D, c.in[20], (bf16_t*)(c.ws + WS_MEMN) + (size_t)(m - M) * D, c.lane);
    }
    { const f32x4* src = (const f32x4*)c.in[2]; u32x2* dst = (u32x2*)(c.ws + WS_KBS); const int n4 = 16 * 256 * 1024 / 4;
      for (int i0 = c.bid * 512 + c.tid; i0 < n4; i0 += 4 * c.G * 512) { f32x4 v[4];
#pragma unroll
          for (int q = 0; q < 4; ++q) { const int i = i0 + q * c.G * 512; v[q] = i < n4 ? src[i] : (f32x4){0.f, 0.f, 0.f, 0.f}; }
#pragma unroll
          for (int q = 0; q < 4; ++q) { const int i = i0 + q * c.G * 512; if (i < n4) { u32x2 w; w.x = pk2(v[q][0], v[q][1]); w.y = pk2(v[q][2], v[q][3]); dst[i] = w; } } } }
}

__device__ __forceinline__ void lru_item(const Ctx& c, int cidx, int h, int mode, LAS unsigned char* wl) {
    int lane = c.lane; asm volatile("" : "+v"(lane));
    const int fr = lane & 15, fq = lane >> 4;
    const bool smp = cidx >= 256; const int sb = cidx - 256; const int cb = cidx >> 7, cc = cidx & 127;
    const int row0 = smp ? MP + 32 * sb : cb * SEQ + 64 * cc; const int len = smp ? 32 : 64;
    const bf16_t* zr = (const bf16_t*)(c.ws + WS_Z + 2 * ZB);
    LAS bf16_t* xt = (LAS bf16_t*)wl;
    { u32x4 v[9];
#pragma unroll
      for (int i = 0; i < 9; ++i) { const int ci = lane + 64 * i, r = ci >> 3, c8 = ci & 7; v[i] = (u32x4){0u, 0u, 0u, 0u};
          const bool halo_special = r < 3 && (smp || cc == 0);
          if (r < len + 3 && !halo_special) v[i] = *(const u32x4*)(zr + (size_t)(row0 - 3 + r) * ZW + 64 * h + 8 * c8);
          if (r < 3 && smp) { const float* st = c.in[5] + (size_t)(sb * 3 + r) * 1024 + 64 * h + 8 * c8; const f32x4 a = *(const f32x4*)st, b = *(const f32x4*)(st + 4); v[i] = (u32x4){pk2(a[0], a[1]), pk2(a[2], a[3]), pk2(b[0], b[1]), pk2(b[2], b[3])}; } }
#pragma unroll
      for (int i = 0; i < 9; ++i) { const int ci = lane + 64 * i, r = ci >> 3, c8 = ci & 7; if (r < 67) *(LAS u32x4*)(xt + r * 72 + 8 * c8) = v[i]; } }
    asm volatile("s_waitcnt lgkmcnt(0)" ::: "memory"); __builtin_amdgcn_wave_barrier();
    { const int ch = 64 * h + lane;
      const float cw0 = c.in[11][ch], cw1 = c.in[11][1024 + ch], cw2 = c.in[11][2048 + ch], cw3 = c.in[11][3072 + ch], cbi = c.in[12][ch];
      float x0 = bf2f(xt[(3 + len - 1) * 72 + lane]), x1 = bf2f(xt[(3 + len - 2) * 72 + lane]), x2 = bf2f(xt[(3 + len - 3) * 72 + lane]);
      if (mode == 1 && (smp || cc == 127)) { float* o = smp ? c.out + O_RCS + (size_t)sb * 3072 + ch : c.out + O_RCP + (size_t)cb * 3072 + ch; o[0] = x2; o[1024] = x1; o[2048] = x0; }
      for (int tb = len - 1; tb >= 0; tb -= 8) { unsigned short rv[8];
#pragma unroll
          for (int i = 0; i < 8; ++i) rv[i] = xt[(tb - i) * 72 + lane];
#pragma unroll
          for (int i = 0; i < 8; ++i) { const float x3 = bf2f(rv[i]);
              xt[(3 + tb - i) * 72 + lane] = (bf16_t)f2bf(cbi + cw0 * x3 + cw1 * x2 + cw2 * x1 + cw3 * x0); x0 = x1; x1 = x2; x2 = x3; } } }
    asm volatile("s_waitcnt lgkmcnt(0)" ::: "memory"); __builtin_amdgcn_wave_barrier();
    const bf16_t* wg = (const bf16_t*)(c.ws + WS_WG) + (size_t)h * 8192;
    bf16x8 wf[8][2];
#pragma unroll
    for (int jt = 0; jt < 8; ++jt)
#pragma unroll
        for (int ks = 0; ks < 2; ++ks) wf[jt][ks] = *(const bf16x8*)(wg + (16 * jt + fr) * 64 + 32 * ks + 8 * fq);
    float sp[4], ba[4], bx[4], hc[4], At[4];
#pragma unroll
    for (int jt = 0; jt < 4; ++jt) { const int cg_ = 64 * h + 16 * jt + fr; const float lam = c.in[17][cg_];
        sp[jt] = -8.f * (lam > 15.f ? __expf(-lam) : log1pf(__expf(-lam)));
        ba[jt] = c.in[14][cg_]; bx[jt] = c.in[16][cg_];
        hc[jt] = mode == 1 ? (smp ? c.in[4][(size_t)sb * 1024 + cg_] : ((const float*)(c.ws + WS_HIN))[(size_t)cidx * 1024 + cg_]) : 0.f; At[jt] = 1.f; }
    bf16_t* ya = (bf16_t*)(c.ws + WS_P);
    const int ntt = len / 16;
    for (int tt = 0; tt < ntt; ++tt) {
        const bf16x8 xb0 = *(const LAS bf16x8*)(xt + (3 + 16 * tt + fr) * 72 + 8 * fq), xb1 = *(const LAS bf16x8*)(xt + (3 + 16 * tt + fr) * 72 + 32 + 8 * fq);
        f32x4 g[8];
#pragma unroll
        for (int jt = 0; jt < 8; ++jt) { g[jt] = (f32x4){0.f, 0.f, 0.f, 0.f}; g[jt] = __builtin_amdgcn_mfma_f32_16x16x32_bf16(xb0, wf[jt][0], g[jt], 0, 0, 0); g[jt] = __builtin_amdgcn_mfma_f32_16x16x32_bf16(xb1, wf[jt][1], g[jt], 0, 0, 0); }
#pragma unroll
        for (int jt = 0; jt < 4; ++jt) {
            float PA[4], PB[4];
#pragma unroll
            for (int j = 0; j < 4; ++j) { const float xv = bf2f(xt[(3 + 16 * tt + 4 * fq + j) * 72 + 16 * jt + fr]);
                const float r = sigm(g[jt][j] + ba[jt]), ig = sigm(g[jt + 4][j] + bx[jt]);
                const float a = __expf(sp[jt] * r); const float b = __builtin_amdgcn_sqrtf(fmaxf(1.f - a * a, 0.f)) * (ig * xv);
                if (j == 0) { PA[0] = a; PB[0] = b; } else { PA[j] = a * PA[j - 1]; PB[j] = a * PB[j - 1] + b; } }
            float TA = PA[3], TB = PB[3];
            { const float pa = __shfl_up(TA, 16), pb = __shfl_up(TB, 16); if (fq >= 1) { TB = TA * pb + TB; TA = TA * pa; } }
            { const float pa = __shfl_up(TA, 32), pb = __shfl_up(TB, 32); if (fq >= 2) { TB = TA * pb + TB; TA = TA * pa; } }
            if (mode == 1) {
                float EA = __shfl_up(TA, 16), EB = __shfl_up(TB, 16); if (fq == 0) { EA = 1.f; EB = 0.f; }
                const float hs = EA * hc[jt] + EB; float hv = 0.f;
#pragma unroll
                for (int j = 0; j < 4; ++j) { hv = PA[j] * hs + PB[j]; ya[(size_t)(row0 + 16 * tt + 4 * fq + j) * ZW + 64 * h + 16 * jt + fr] = (bf16_t)f2bf(hv); }
                hc[jt] = __shfl(hv, 48 + fr);
            } else { const float tA = __shfl(TA, 48 + fr), tB = __shfl(TB, 48 + fr); hc[jt] = tA * hc[jt] + tB; At[jt] *= tA; }
        }
    }
    if (fq == 0) {
#pragma unroll
        for (int jt = 0; jt < 4; ++jt) { const int cg_ = 64 * h + 16 * jt + fr;
            if (mode == 0) { ((float*)(c.ws + WS_AGGA))[(size_t)cidx * 1024 + cg_] = At[jt]; ((float*)(c.ws + WS_AGGB))[(size_t)cidx * 1024 + cg_] = hc[jt]; }
            else if (smp) c.out[O_RHS + (size_t)sb * 1024 + cg_] = hc[jt];
            else if (cc == 127) c.out[O_RHP + (size_t)cb * 1024 + cg_] = hc[jt]; }
    }
    asm volatile("s_waitcnt lgkmcnt(0)" ::: "memory"); __builtin_amdgcn_wave_barrier();
}

struct HgItem { int row0, len, h; };
__device__ __forceinline__ HgItem hg_decode(int it) { HgItem r; if (it < 2048) { const int b = it >> 10, rem = it & 1023; r.row0 = b * SEQ + 64 * (rem >> 3); r.len = 64; r.h = rem & 7; } else { const int j = it - 2048; r.row0 = MP + 32 * (j >> 3); r.len = 32; r.h = j & 7; } return r; }
__device__ __forceinline__ bf16_t* hg_U(const Ctx& c, int it) { return it < 2048 ? (bf16_t*)((unsigned char*)c.out + DO_U) + (size_t)it * 16384 : (bf16_t*)(c.ws + WS_US) + (size_t)(it - 2048) * 16384; }
__device__ __forceinline__ bf16_t* hg_ST(const Ctx& c, int it) { return it < 2048 ? (bf16_t*)((unsigned char*)c.out + DO_ST) + (size_t)it * 16384 : (bf16_t*)(c.ws + WS_STS) + (size_t)(it - 2048) * 16384; }

__device__ __forceinline__ void hg_gates(const Ctx& c, int tid, const HgItem& I, LAS float* psum, float (&g)[16], float (&kk)[16], float& boff, float& btot) {
    const int q = tid >> 7, k = tid & 127; const bf16_t* zf = (const bf16_t*)(c.ws + WS_Z + 4 * ZB);
    const float l0 = c.in[18][I.h * 128 + k], l1 = c.in[18][1024 + I.h * 128 + k]; const float lb = sigm(l0 - l1);
    float s = 0.f;
#pragma unroll
    for (int i = 0; i < 16; ++i) { const int t = 16 * q + i; const bool ok = t < I.len; const int tr = ok ? t : 0;
        const float fr_ = bf2f(zf[(size_t)(I.row0 + tr) * ZW + I.h * 128 + k]); const float f = lb + (1.f - lb) * sigm(fr_);
        const float gv = ok ? __logf(f) : 0.f; g[i] = gv; kk[i] = ok ? 1.f - f : 0.f; s += gv; }
    psum[q * 128 + k] = s;
    __syncthreads();
    const float p0 = psum[k], p1 = psum[128 + k], p2 = psum[256 + k], p3 = psum[384 + k];
    boff = q == 0 ? 0.f : (q == 1 ? p0 : (q == 2 ? p0 + p1 : p0 + p1 + p2)); btot = (p0 + p1) + (p2 + p3);
}
__device__ __forceinline__ void hg_vt_fetch(const Ctx& c, int tid, const HgItem& I, unsigned (&w)[8]) {
    const int q = tid >> 7, v = tid & 127; const bf16_t* zi = (const bf16_t*)(c.ws + WS_Z + 5 * ZB);
#pragma unroll
    for (int i = 0; i < 8; ++i) { const int t = 16 * q + 2 * i; const bool ok = t < I.len; const int tr = ok ? t : 0;
        const unsigned lo = zi[(size_t)(I.row0 + tr) * ZW + I.h * 128 + v], hi = zi[(size_t)(I.row0 + tr + 1) * ZW + I.h * 128 + v];
        w[i] = ok ? (lo | (hi << 16)) : 0u; }
}
__device__ __forceinline__ void hg_vt_store(int tid, LAS bf16_t* VT, const unsigned (&w)[8]) {
    const int q = tid >> 7, v = tid & 127;
    *(LAS u32x4*)(VT + v * 72 + 16 * q) = (u32x4){w[0], w[1], w[2], w[3]}; *(LAS u32x4*)(VT + v * 72 + 16 * q + 8) = (u32x4){w[4], w[5], w[6], w[7]};
}
__device__ __forceinline__ void hg_pass1(const Ctx& c, int it) {
    const HgItem I = hg_decode(it);
    LAS bf16_t* KdT = (LAS bf16_t*)c.lds;
    LAS bf16_t* VT = (LAS bf16_t*)(c.lds + 18432);
    LAS float* psum = (LAS float*)(c.lds + 36864);
    float g[16], kk[16], boff, btot;
    int tid = c.tid; asm volatile("" : "+v"(tid));
    unsigned vw[8]; hg_vt_fetch(c, tid, I, vw);
    hg_gates(c, tid, I, psum, g, kk, boff, btot);
    const int q = tid >> 7, k = tid & 127;
    { float bc = boff; unsigned w[8];
#pragma unroll
      for (int i = 0; i < 8; ++i) { bc += g[2 * i]; const float a = kk[2 * i] * __expf(btot - bc); bc += g[2 * i + 1]; const float b = kk[2 * i + 1] * __expf(btot - bc); w[i] = pk2(a, b); }
      *(LAS u32x4*)(KdT + k * 72 + 16 * q) = (u32x4){w[0], w[1], w[2], w[3]}; *(LAS u32x4*)(KdT + k * 72 + 16 * q + 8) = (u32x4){w[4], w[5], w[6], w[7]}; }
    if (q == 0) ((float*)(c.ws + WS_DBUF))[(size_t)it * 128 + k] = __expf(btot);
    hg_vt_store(tid, VT, vw);
    __syncthreads();
    const int fr = tid & 15, fq = (tid >> 4) & 3, w = c.wave;
    const bf16x8 a0 = *(const LAS bf16x8*)(KdT + (16 * w + fr) * 72 + 8 * fq), a1 = *(const LAS bf16x8*)(KdT + (16 * w + fr) * 72 + 32 + 8 * fq);
    bf16_t* U = hg_U(c, it);
#pragma unroll
    for (int vt = 0; vt < 8; ++vt) {
        const bf16x8 b0 = *(const LAS bf16x8*)(VT + (16 * vt + fr) * 72 + 8 * fq), b1 = *(const LAS bf16x8*)(VT + (16 * vt + fr) * 72 + 32 + 8 * fq);
        f32x4 acc = (f32x4){0.f, 0.f, 0.f, 0.f};
        acc = __builtin_amdgcn_mfma_f32_16x16x32_bf16(a0, b0, acc, 0, 0, 0); acc = __builtin_amdgcn_mfma_f32_16x16x32_bf16(a1, b1, acc, 0, 0, 0);
        u32x2 o; o.x = pk2(acc[0], acc[1]); o.y = pk2(acc[2], acc[3]);
        *(u32x2*)(U + (size_t)(16 * vt + fr) * 128 + 16 * w + 4 * fq) = o;
    }
    __syncthreads();
}
__device__ __forceinline__ void hg_scan(const Ctx& c) {
    const float* dbuf = (const float*)(c.ws + WS_DBUF);
    LAS float* dl = (LAS float*)c.lds;
    for (int p0 = c.bid * 512; p0 < 16 * 8192; p0 += c.G * 512) {
        const int seq = p0 >> 13, b = seq >> 3, h = seq & 7;
        __syncthreads();
        { f32x4 t[8];
#pragma unroll
          for (int i = 0; i < 8; ++i) { const int q = c.tid + 512 * i, ch = q >> 5, k4 = q & 31; t[i] = *(const f32x4*)(dbuf + ((size_t)b * 1024 + ch * 8 + h) * 128 + 4 * k4); }
#pragma unroll
          for (int i = 0; i < 8; ++i) ((LAS f32x4*)dl)[c.tid + 512 * i] = t[i]; }
        __syncthreads();
        const int p = p0 + c.tid, pe = p & 8191, v = pe >> 6, k2 = (pe & 63) * 2;
        float s0 = 0.f, s1 = 0.f;
        const unsigned* __restrict__ Up = (const unsigned*)((unsigned char*)c.out + DO_U); unsigned* __restrict__ Sp = (unsigned*)((unsigned char*)c.out + DO_ST);
        const size_t e0 = ((size_t)b * 1024 + h) * 8192 + (size_t)v * 64 + (k2 >> 1);
        for (int cb0 = 0; cb0 < 128; cb0 += 32) {
            unsigned u[32];
#pragma unroll
            for (int i = 0; i < 32; ++i) u[i] = Up[e0 + (size_t)(cb0 + i) * 65536];
#pragma unroll
            for (int i = 0; i < 32; ++i) { const f32x2 d = *(const LAS f32x2*)(dl + (cb0 + i) * 128 + k2);
                __builtin_nontemporal_store(cvt_pk_bf16(s0, s1), &Sp[e0 + (size_t)(cb0 + i) * 65536]); s0 = d[0] * s0 + bflo(u[i]); s1 = d[1] * s1 + bfhi(u[i]); }
        }
        float* o = c.out + O_HGP + (size_t)seq * 16384; o[(size_t)k2 * 128 + v] = s0; o[(size_t)(k2 + 1) * 128 + v] = s1;
    }
    __syncthreads();
    for (int p = c.bid * 512 + c.tid; p < 128 * 16384; p += c.G * 512) {
        const int seq = p >> 14, e = p & 16383, k = e >> 7, v = e & 127; const int it = 2048 + seq;
        const float s = c.in[6][p]; const float d = dbuf[(size_t)it * 128 + k]; const float u = bf2f(((const bf16_t*)(c.ws + WS_US))[(size_t)seq * 16384 + v * 128 + k]);
        c.out[O_HGS + p] = d * s + u;
    }
}
__device__ __forceinline__ void hg_pass3(const Ctx& c, int it) {
    const HgItem I = hg_decode(it);
    LAS bf16_t* Q0 = (LAS bf16_t*)c.lds;
    LAS bf16_t* QE = (LAS bf16_t*)(c.lds + 17408);
    LAS bf16_t* KE = (LAS bf16_t*)(c.lds + 34816);
    LAS bf16_t* VT = (LAS bf16_t*)(c.lds + 52224);
    LAS bf16_t* AM = (LAS bf16_t*)(c.lds + 70656);
    LAS bf16_t* STl = (LAS bf16_t*)(c.lds + 79872);
    LAS float* psum = (LAS float*)(c.lds + 114688);
    LAS float* red = (LAS float*)(c.lds + 116736);
    float g[16], kk[16], boff, btot;
    int tid = c.tid; asm volatile("" : "+v"(tid));
    unsigned vw[8]; hg_vt_fetch(c, tid, I, vw);
    u32x4 stv[4]; { const u32x4* src = (const u32x4*)hg_ST(c, it);
#pragma unroll
      for (int i = 0; i < 4; ++i) stv[i] = src[tid + 512 * i]; }
    unsigned short qraw[16]; { const bf16_t* zq = (const bf16_t*)(c.ws + WS_Z + 3 * ZB); const int q_ = tid >> 7, k_ = tid & 127;
#pragma unroll
      for (int i = 0; i < 16; ++i) { const int t = 16 * q_ + i; const int tr = t < I.len ? t : 0; qraw[i] = zq[(size_t)(I.row0 + tr) * ZW + I.h * 128 + k_]; } }
    hg_gates(c, tid, I, psum, g, kk, boff, btot);
    const int q = tid >> 7, k = tid & 127;
    {
      const float p0 = psum[k], p1 = psum[128 + k]; const float ref = I.len == 64 ? p0 + p1 : p0;
      float bc = boff;
#pragma unroll
      for (int i = 0; i < 16; ++i) { const int t = 16 * q + i; bc += g[i]; const bool ok = t < I.len;
          float qv = bf2f(qraw[i]); qv = ok ? qv : 0.f;
          Q0[t * 136 + k] = (bf16_t)f2bf(qv * __expf(bc)); QE[t * 136 + k] = (bf16_t)f2bf(qv * __expf(bc - ref)); KE[t * 136 + k] = (bf16_t)f2bf(kk[i] * __expf(ref - bc)); } }
    hg_vt_store(tid, VT, vw);
    {
#pragma unroll
      for (int i = 0; i < 4; ++i) { const int ci = tid + 512 * i; const int v = ci >> 4, kc = ci & 15; *(LAS u32x4*)(STl + v * 136 + 8 * kc) = stv[i]; } }
    __syncthreads();
    const int fr = tid & 15, fq = (tid >> 4) & 3, w = c.wave;
    { const int tt = w >> 1;
#pragma unroll
      for (int si = 0; si < 2; ++si) { const int st = 2 * (w & 1) + si; f32x4 acc = (f32x4){0.f, 0.f, 0.f, 0.f};
          if (st <= tt) {
#pragma unroll
              for (int ks = 0; ks < 4; ++ks) { const bf16x8 a = *(const LAS bf16x8*)(QE + (16 * tt + fr) * 136 + 32 * ks + 8 * fq), b = *(const LAS bf16x8*)(KE + (16 * st + fr) * 136 + 32 * ks + 8 * fq);
                  acc = __builtin_amdgcn_mfma_f32_16x16x32_bf16(a, b, acc, 0, 0, 0); } }
#pragma unroll
          for (int j = 0; j < 4; ++j) { const int t = 16 * tt + 4 * fq + j, s = 16 * st + fr; AM[t * 72 + s] = (bf16_t)f2bf(s <= t ? acc[j] : 0.f); } } }
    __syncthreads();
    const int tt = w & 3, vh = w >> 2;
    bf16x8 bq[4], ba_[2];
#pragma unroll
    for (int ks = 0; ks < 4; ++ks) bq[ks] = *(const LAS bf16x8*)(Q0 + (16 * tt + fr) * 136 + 32 * ks + 8 * fq);
#pragma unroll
    for (int ks = 0; ks < 2; ++ks) ba_[ks] = *(const LAS bf16x8*)(AM + (16 * tt + fr) * 72 + 32 * ks + 8 * fq);
    f32x4 o[4]; float ss = 0.f;
#pragma unroll
    for (int vi = 0; vi < 4; ++vi) { const int vt = 4 * vh + vi; o[vi] = (f32x4){0.f, 0.f, 0.f, 0.f};
#pragma unroll
        for (int ks = 0; ks < 4; ++ks) { const bf16x8 a = *(const LAS bf16x8*)(STl + (16 * vt + fr) * 136 + 32 * ks + 8 * fq); o[vi] = __builtin_amdgcn_mfma_f32_16x16x32_bf16(a, bq[ks], o[vi], 0, 0, 0); }
#pragma unroll
        for (int ks = 0; ks < 2; ++ks) { const bf16x8 a = *(const LAS bf16x8*)(VT + (16 * vt + fr) * 72 + 32 * ks + 8 * fq); o[vi] = __builtin_amdgcn_mfma_f32_16x16x32_bf16(a, ba_[ks], o[vi], 0, 0, 0); }
        ss += (o[vi][0] * o[vi][0] + o[vi][1] * o[vi][1]) + (o[vi][2] * o[vi][2] + o[vi][3] * o[vi][3]); }
    ss += __shfl_xor(ss, 16); ss += __shfl_xor(ss, 32);
    if (fq == 0) red[vh * 64 + 16 * tt + fr] = ss;
    __syncthreads();
    const int t = 16 * tt + fr;
    if (t < I.len) { const float rs = rsqrtf((red[t] + red[64 + t]) * (1.f / 128.f) + EPS);
        bf16_t* yb = (bf16_t*)(c.ws + WS_Z + 0 * ZB) + (size_t)(I.row0 + t) * ZW + I.h * 128;
#pragma unroll
        for (int vi = 0; vi < 4; ++vi) { const int v0 = 16 * (4 * vh + vi) + 4 * fq; const u32x2 og = *(const u32x2*)(yb + v0); const f32x4 gn = *(const f32x4*)(c.in[19] + v0);
            u32x2 wv; wv.x = pk2(o[vi][0] * rs * gn[0] * sigm(bflo(og.x)), o[vi][1] * rs * gn[1] * sigm(bfhi(og.x))); wv.y = pk2(o[vi][2] * rs * gn[2] * sigm(bflo(og.y)), o[vi][3] * rs * gn[3] * sigm(bfhi(og.y)));
            *(u32x2*)(yb + v0) = wv; } }
    __syncthreads();
}

__device__ __forceinline__ float load_pre_row(const Ctx& c, int m, const bf16_t* Y, const float* slab, int nsl, f32x4 (&y)[8]) {
    float s = 0.f;
    if (m < MP) { const u32x2* yp = (const u32x2*)(Y + (size_t)m * D) + c.lane;
#pragma unroll
        for (int j = 0; j < 8; ++j) { const u32x2 w = yp[64 * j]; y[j] = (f32x4){bflo(w.x), bfhi(w.x), bflo(w.y), bfhi(w.y)}; } }
    else {
#pragma unroll
        for (int j = 0; j < 8; ++j) y[j] = (f32x4){0.f, 0.f, 0.f, 0.f};
        for (int sl = 0; sl < nsl; ++sl) { const f32x4* sp = (const f32x4*)(slab + ((size_t)sl * 512 + (m - MP)) * D) + c.lane;
#pragma unroll
            for (int j = 0; j < 8; ++j) y[j] += sp[64 * j]; } }
#pragma unroll
    for (int j = 0; j < 8; ++j) s += (y[j][0] * y[j][0] + y[j][1] * y[j][1]) + (y[j][2] * y[j][2] + y[j][3] * y[j][3]);
    return wave_sum(s);
}
__device__ __forceinline__ void phase_norm_mid(const Ctx& c) {
    const int gw = c.bid * 8 + c.wave, NGW = c.G * 8;
    for (int m = gw; m < M; m += NGW) {
        f32x4 y[8]; const float rs = rsqrtf(load_pre_row(c, m, (const bf16_t*)(c.ws + WS_YPRE), (const float*)(c.ws + WS_SLAB6), 8, y) * (1.f / D) + EPS);
        const f32x4* xr = (const f32x4*)xrow_ptr(c, m) + c.lane; float s2 = 0.f;
        u32x2* xf = (u32x2*)((bf16_t*)(c.ws + WS_XF) + (size_t)m * D) + c.lane;
#pragma unroll
        for (int j = 0; j < 8; ++j) { const f32x4 x = xr[64 * j]; const f32x4 g = ((const f32x4*)c.in[25])[c.lane + 64 * j];
            y[j] = x + y[j] * rs * g; s2 += (y[j][0] * y[j][0] + y[j][1] * y[j][1]) + (y[j][2] * y[j][2] + y[j][3] * y[j][3]);
            u32x2 w; w.x = cvt_pk_bf16(y[j][0], y[j][1]); w.y = cvt_pk_bf16(y[j][2], y[j][3]); xf[64 * j] = w; }
        const float r2 = rsqrtf(wave_sum(s2) * (1.f / D) + EPS);
        if (c.lane == 0) ((float*)(c.ws + WS_R2))[m] = r2;
    }
}
__device__ __forceinline__ void phase_norm_fin(const Ctx& c) {
    const int gw = c.bid * 8 + c.wave, NGW = c.G * 8;
    for (int m = gw; m < M; m += NGW) {
        f32x4 y[8]; const float rs = rsqrtf(load_pre_row(c, m, (const bf16_t*)(c.ws + WS_YPRE2), (const float*)(c.ws + WS_SLAB9), 11, y) * (1.f / D) + EPS);
        f32x4* o = (f32x4*)(c.out + (size_t)m * D) + c.lane; const u32x2* x1 = (const u32x2*)((const bf16_t*)(c.ws + WS_XF) + (size_t)m * D) + c.lane;
#pragma unroll
        for (int j = 0; j < 8; ++j) { const f32x4 g = ((const f32x4*)c.in[31])[c.lane + 64 * j]; const u32x2 w = x1[64 * j];
            o[64 * j] = (f32x4){bflo(w.x), bfhi(w.x), bflo(w.y), bfhi(w.y)} + y[j] * rs * g; }
    }
}

#define XB_TMO      128
#define XB_XCNT(j)  (256  + 64 * (j))
#define XB_XSUB(j)  (1280 + 64 * (j))
#define XB_XGEN(j)  (2304 + 64 * (j))
#define XB_TOP      3328
#define XB_TOPGEN   3392
#define XCD_BAR_WORDS 3456
#define XB_SPIN_CAP (1u << 20)
__device__ __forceinline__ unsigned xb_ld(unsigned* p)              { return __hip_atomic_load(p, __ATOMIC_RELAXED, __HIP_MEMORY_SCOPE_AGENT); }
__device__ __forceinline__ unsigned xb_add(unsigned* p, unsigned v) { return __hip_atomic_fetch_add(p, v, __ATOMIC_RELAXED, __HIP_MEMORY_SCOPE_AGENT); }
__device__ __forceinline__ unsigned xb_xcc_id() { return (unsigned)__builtin_amdgcn_s_getreg((3 << 11) | 20) & 0xFu; }
#define XB_SPIN(cond, bar) do { unsigned _sp = 0; while (cond) { __builtin_amdgcn_s_sleep(1); \
    if ((++_sp & 255u) == 0u) { if (xb_ld(&(bar)[XB_TMO])) break; if (_sp > XB_SPIN_CAP) { atomicAdd(&(bar)[XB_TMO], 1u); break; } } } } while (0)
struct XcdBarrier { unsigned* bar; unsigned x; volatile LAS unsigned* st; };
__device__ __forceinline__ XcdBarrier xcd_barrier_post(unsigned* bar, volatile LAS unsigned* st) {
    XcdBarrier b; b.bar = bar; b.x = xb_xcc_id(); b.st = st;
    if (threadIdx.x == 0) (void)xb_add(&bar[XB_XCNT(b.x)], 1u);
    return b;
}
__device__ __forceinline__ void xcd_barrier_complete(unsigned* bar, unsigned x, unsigned& nloc, unsigned& nx) {
    const unsigned G = gridDim.x * gridDim.y * gridDim.z;
    unsigned sum, cnt, mine, sp = 0u;
    for (;;) {
        sum = 0u; cnt = 0u; mine = 0u;
#pragma unroll
        for (unsigned j = 0; j < 16; ++j) { const unsigned c = xb_ld(&bar[XB_XCNT(j)]); sum += c; cnt += (c > 0u) ? 1u : 0u; mine = (j == x) ? c : mine; }
        if (sum == G) break;
        __builtin_amdgcn_s_sleep(1);
        if ((++sp & 255u) == 0u) { if (xb_ld(&bar[XB_TMO])) break; if (sp > XB_SPIN_CAP) { atomicAdd(&bar[XB_TMO], 1u); break; } }
    }
    nloc = mine > 0u ? mine : 1u; nx = cnt > 0u ? cnt : 1u;
}
__device__ __forceinline__ void xcd_barrier(const XcdBarrier& b) {
    asm volatile("s_waitcnt vmcnt(0)" ::: "memory");
    __syncthreads();
    if (threadIdx.x == 0) {
        unsigned* bar = b.bar;
        __builtin_amdgcn_s_waitcnt(0);
        unsigned nloc = b.st[0], nx = b.st[1];
        if (nloc == 0u) { xcd_barrier_complete(bar, b.x, nloc, nx); b.st[0] = nloc; b.st[1] = nx; }
        const unsigned old = xb_add(&bar[XB_XSUB(b.x)], 1u);
        const unsigned gen = old / nloc;
        if (old + 1u == (gen + 1u) * nloc) {
            __builtin_amdgcn_fence(__ATOMIC_RELEASE, "agent");
            asm volatile("s_waitcnt vmcnt(0)" ::: "memory");
            const unsigned og = xb_add(&bar[XB_TOP], 1u);
            const unsigned tg = og / nx;
            if (og + 1u == (tg + 1u) * nx) xb_add(&bar[XB_TOPGEN], 1u);
            else XB_SPIN(xb_ld(&bar[XB_TOPGEN]) == tg, bar);
            __builtin_amdgcn_fence(__ATOMIC_ACQUIRE, "agent");
            xb_add(&bar[XB_XGEN(b.x)], 1u);
            asm volatile("s_waitcnt vmcnt(0)" ::: "memory");
        } else {
            XB_SPIN(xb_ld(&bar[XB_XGEN(b.x)]) == gen, bar);
            __builtin_amdgcn_fence(__ATOMIC_ACQUIRE, "agent");
            asm volatile("s_waitcnt vmcnt(0)" ::: "memory");
        }
    }
    __syncthreads();
}

struct Args { const float* in[32]; float* out; unsigned char* ws; int ph_lo, ph_hi, rep, pad; };

__global__ void __launch_bounds__(512, 2) fwd_kernel(Args args) {
    extern __shared__ __attribute__((aligned(16))) unsigned char lds_raw[];
    Ctx c; c.lds = (LAS unsigned char*)lds_raw; c.tid = threadIdx.x; c.lane = c.tid & 63; c.wave = __builtin_amdgcn_readfirstlane(c.tid >> 6); c.G = gridDim.x; c.bid = blockIdx.x;
    c.in = args.in; c.out = args.out; c.ws = args.ws;
    const int lo = args.ph_lo, hi = args.ph_hi;
#define REP(bit) for (int r_ = 0, n_ = 1 + ((args.rep >> (bit)) & 1); r_ < n_; ++r_)
    const int gw = c.bid * 8 + c.wave, NGW = c.G * 8;
    bf16_t* Z = (bf16_t*)(c.ws + WS_Z);
#ifndef PHMASK
#define PHMASK 0x7ff
#endif
#define IN(k) (((PHMASK >> (k)) & 1) && lo <= (k) && (k) < hi)
#define SEAM(k) do { if (IN(k) && IN((k) + 1)) { xcd_barrier(bar); } } while (0)
    volatile LAS unsigned* misc = (volatile LAS unsigned*)(c.lds + 131072);
    if (c.tid < 8) misc[c.tid] = 0u;
    __syncthreads();
    XcdBarrier bar = xcd_barrier_post((unsigned*)c.ws, misc);
    if (lo < 0) cg::this_grid().sync();

    if (IN(0)) { REP(0) phase_prep(c); }
    SEAM(0);
    if (IN(1)) {
        { OpPlain op{(const bf16_t*)((unsigned char*)c.out + DO_XN), (const bf16_t*)((unsigned char*)c.out + DO_WIN), 2048, 2048, 2048}; Order S; S.init(M / 256, 48, c.G, c.bid, 1, WGM_P1);
          EpiZ E{Z}; pg8::gemm_phase<EpiZ, OpPlain>(c.lds, op, S, E); }
        __syncthreads();
        if (c.G == 256 && c.bid >= 96 && c.bid < c.G - 16) prep_late(c, (c.bid - 96) * 8 + c.wave, 144 * 8);
        else if (c.G != 256) prep_late(c, c.bid * 8 + c.wave, c.G * 8);
        if (c.bid >= c.G - 16) {
          OpPlain op{(const bf16_t*)(c.ws + WS_MEMN), (const bf16_t*)(c.ws + WS_WKV), 2048, 2048, 2048}; Order S; S.init(2, 8, 16, c.bid - (c.G - 16));
          EpiKV E{c.out, (bf16_t*)(c.ws + WS_KBP)}; pg8::gemm_phase<EpiKV, OpPlain>(c.lds, op, S, E); }
    }
    SEAM(1);
    if (IN(2)) {
#if !defined(P2SEL) || P2SEL==0
        { OpAttn op{Z + 1 * (size_t)M * ZW, (const bf16_t*)(c.ws + WS_KBP), (const bf16_t*)(c.ws + WS_KBS), 256, 1024, 1024, 0}; Order S; S.init(320, 1, c.G, c.bid);
          EpiS E{(bf16_t*)(c.ws + WS_P), (float*)(c.ws + WS_RS)}; pg8::gemm_phase<EpiS, OpAttn>(c.lds, op, S, E); }
#endif
        __syncthreads();
        { LAS float* scr = (LAS float*)(c.lds + c.wave * 16384);
          for (int r = gw - 64 * 8; r >= 0 && r < 2 * 128; r += NGW) { const int b = r >> 7; transpose_job(c.out + O_MV + (size_t)b * 262144, 256, 1024, (bf16_t*)(c.ws + WS_VTP) + (size_t)b * 262144, 256, r & 127, scr, c.lane, [](int n0) { return n0; }); } }
        __syncthreads();
#if !defined(P2SEL) || P2SEL==1
        REP(1) for (int it = c.G - 1 - c.bid; it < 2176; it += c.G) hg_pass1(c, it);
#endif
        __syncthreads();
#if !defined(P2SEL) || P2SEL==2
        REP(2) for (int r = gw; r < 256 * 16; r += NGW) lru_item(c, r >> 4, r & 15, 0, c.lds + c.wave * 9728);
#endif
    }
    SEAM(2);
    if (IN(3)) {
        { OpAttn op{(const bf16_t*)(c.ws + WS_P), (const bf16_t*)(c.ws + WS_VTP), (const bf16_t*)(c.ws + WS_VTS), 256, 1024, 256, 1}; Order S; S.init(320, 1, c.G, c.bid);
          EpiPV E{Z + 1 * (size_t)M * ZW, (const float*)(c.ws + WS_RS)}; pg8::gemm_phase<EpiPV, OpAttn>(c.lds, op, S, E); }
        __syncthreads();
        for (int p = (c.G - 1 - c.bid) * 512 + c.tid; p < 2048; p += c.G * 512) { const int b = p >> 10, ch = p & 1023; float h = 0.f;
            const float* A = (const float*)(c.ws + WS_AGGA); const float* B = (const float*)(c.ws + WS_AGGB); float* H = (float*)(c.ws + WS_HIN);
            for (int k0 = 0; k0 < 128; k0 += 16) { float av[16], bv[16];
#pragma unroll
                for (int i = 0; i < 16; ++i) { const size_t e = (size_t)(b * 128 + k0 + i) * 1024 + ch; av[i] = A[e]; bv[i] = B[e]; }
#pragma unroll
                for (int i = 0; i < 16; ++i) { const size_t e = (size_t)(b * 128 + k0 + i) * 1024 + ch; H[e] = h; h = av[i] * h + bv[i]; } } }
        REP(3) hg_scan(c);
    }
    SEAM(3);
    if (IN(4)) {
        for (int it = c.bid; it < 2176; it += c.G) hg_pass3(c, it);
        __syncthreads();
        for (int r = NGW - 1 - gw; r < 272 * 16; r += NGW) lru_item(c, r >> 4, r & 15, 1, c.lds + c.wave * 9728);
    }
    SEAM(4);
    if (IN(5)) {
        const bool conv_first = (c.bid & 1) != 0; const bool full = c.G == 256;
        for (int pass = 0; pass < 2; ++pass) {
            if ((pass == 0) == conv_first) {
                if (!full || c.bid >= 48) {
                  LAS float* scr = (LAS float*)(c.lds + c.wave * 16384); constexpr int I_UP = 32 * 352, I_DN = 88 * 64;
                  const int w0 = full ? (c.bid - 48) * 8 + c.wave : c.bid * 8 + c.wave, nw = full ? (c.G - 48) * 8 : c.G * 8;
                  for (int it = w0; it < (full ? I_UP : I_UP + I_DN); it += nw) {
                      if (it < I_UP) transpose_job(c.in[27], 2048, 11264, (bf16_t*)(c.ws + WS_WUP), 2048, it, scr, c.lane, [](int n0) { const int isv = n0 >= FF, n = isv ? n0 - FF : n0; return (n >> 7) * 256 + isv * 128 + (n & 127); }, c.in[26]);
                      else transpose_job(c.in[30], FF, 2048, (bf16_t*)(c.ws + WS_WDN), FF, it - I_UP, scr, c.lane, [](int n0) { return n0; }); } }
            } else {
                OpMerge op{(const bf16_t*)(c.ws + WS_P), Z + 0 * (size_t)M * ZW, Z + 1 * (size_t)M * ZW, (const bf16_t*)(c.ws + WS_WBR), 1024, 1024, 1024}; pg8::MergeOrder S; S.init(M / 256, 8, c.G, c.bid, pg8::WGM);
                EpiMerge E{Z + 6 * (size_t)M * ZW, c.in[23], (bf16_t*)(c.ws + WS_MM), (unsigned*)c.ws + 4096}; pg8::gemm_phase<EpiMerge, OpMerge, pg8::MergeOrder>(c.lds, op, S, E);
            }
            __syncthreads();
        }
    }
    SEAM(5);
    if (IN(6)) {
        { OpPlain op{(const bf16_t*)(c.ws + WS_MM), (const bf16_t*)(c.ws + WS_WOUT), 2048, 2048, 2048}; Order S; S.init(MP / 256, 8, c.G, c.bid);
          EpiPre E{(bf16_t*)(c.ws + WS_YPRE)}; pg8::gemm_phase<EpiPre, OpPlain>(c.lds, op, S, E); }
        __syncthreads();
        { OpSplit op{(const bf16_t*)(c.ws + WS_MM), (const bf16_t*)(c.ws + WS_WOUT), 256, 2048, 2048}; Order S; S.init(2 * 8, 8, c.G, c.bid);
          EpiSlab E{(float*)(c.ws + WS_SLAB6)}; pg8::gemm_phase<EpiSlab, OpSplit>(c.lds, op, S, E); }
    }
    SEAM(6);
    if (IN(7)) { REP(7) phase_norm_mid(c); }
    SEAM(7);
    if (IN(8)) {
        OpUp op{(const bf16_t*)(c.ws + WS_XF), (const bf16_t*)(c.ws + WS_WUP), 2048, 2048, 2048}; Order S; S.init(68, 44, c.G, c.bid, 1, WGM_P8);
        EpiUp E{(bf16_t*)(c.ws + WS_ACT), c.in[28], c.in[29], c.in[7], c.out, (const float*)(c.ws + WS_R2)}; pg8::gemm_phase<EpiUp, OpUp>(c.lds, op, S, E);
        __syncthreads();
        if (c.G == 256 && c.bid >= 176) {
          LAS float* scr = (LAS float*)(c.lds + c.wave * 16384); constexpr int I_DN = 88 * 64;
          for (int it = (c.bid - 176) * 8 + c.wave; it < I_DN; it += 80 * 8) transpose_job(c.in[30], FF, 2048, (bf16_t*)(c.ws + WS_WDN), FF, it, scr, c.lane, [](int n0) { return n0; }); }
    }
    SEAM(8);
    if (IN(9)) {
        { OpPlain op{(const bf16_t*)(c.ws + WS_ACT), (const bf16_t*)(c.ws + WS_WDN), FF, FF, FF}; Order S; S.init(MP / 256, 8, c.G, c.bid);
          EpiPre E{(bf16_t*)(c.ws + WS_YPRE2)}; pg8::gemm_phase<EpiPre, OpPlain>(c.lds, op, S, E); }
        __syncthreads();
        { OpSplit op{(const bf16_t*)(c.ws + WS_ACT), (const bf16_t*)(c.ws + WS_WDN), 512, FF, FF}; Order S; S.init(2 * 11, 8, c.G, c.bid);
          EpiSlab E{(float*)(c.ws + WS_SLAB9)}; pg8::gemm_phase<EpiSlab, OpSplit>(c.lds, op, S, E); }
    }
    SEAM(9);
    if (IN(10)) { phase_norm_fin(c); }
#undef IN
#undef SEAM
}

extern "C" void kernel_launch(void* const* d_in, const int* in_sizes, int n_in, void* d_out, int out_size, void* d_ws, size_t ws_size, hipStream_t stream) {
    static int grid = 0;
    if (grid == 0) {
        if (n_in != 32 || (size_t)out_size != O_END || ws_size < WS_END) { fprintf(stderr, "kernel_launch: unexpected shapes (n_in %d out %d ws %zu)\n", n_in, out_size, ws_size); grid = -1; return; }
        int dev = 0, cus = 0, per_cu = 0;
        hipGetDevice(&dev); hipDeviceGetAttribute(&cus, hipDeviceAttributeMultiprocessorCount, dev);
        hipFuncSetAttribute((const void*)fwd_kernel, hipFuncAttributeMaxDynamicSharedMemorySize, LDS_BYTES);
        hipOccupancyMaxActiveBlocksPerMultiprocessor(&per_cu, (const void*)fwd_kernel, 512, LDS_BYTES);
        if (per_cu < 1) per_cu = 1;
        grid = cus * 1;
        (void)hipGetLastError();
    }
    if (grid < 0) return;
    if (hipMemsetAsync(d_ws, 0, 32768, stream) != hipSuccess) { fprintf(stderr, "memset failed\n"); return; }
    Args a{};
    for (int i = 0; i < 32; ++i) a.in[i] = (const float*)d_in[i];
    a.out = (float*)d_out; a.ws = (unsigned char*)d_ws;
#if MK_LAUNCHES == 1
    a.ph_lo = 0; a.ph_hi = NPH;
    void* kargs[] = {&a};
    hipError_t e = hipLaunchCooperativeKernel((const void*)fwd_kernel, dim3(grid), dim3(512), kargs, LDS_BYTES, stream);
    if (e != hipSuccess) fprintf(stderr, "cooperative launch failed: %s (grid %d)\n", hipGetErrorString(e), grid);
#else
#ifdef REPMASK
    a.rep = REPMASK;
#endif
    for (int p = 0; p < NPH; ++p) { a.ph_lo = p; a.ph_hi = p + 1; hipLaunchKernelGGL(fwd_kernel, dim3(grid), dim3(512), LDS_BYTES, stream, a);
#ifdef DUPMASK
        if ((DUPMASK >> p) & 1) hipLaunchKernelGGL(fwd_kernel, dim3(grid), dim3(512), LDS_BYTES, stream, a);
#endif
    }
#endif
}
```

```cpp
#include <hip/hip_runtime.h>
#include <hip/hip_cooperative_groups.h>
#include <cstdio>
#include <cstdint>
namespace cg = cooperative_groups;

#ifndef MK_LAUNCHES
#define MK_LAUNCHES 1
#endif

#define LAS __attribute__((address_space(3)))
typedef unsigned short bf16_t;
typedef short bf16x8 __attribute__((ext_vector_type(8)));
typedef float f32x4 __attribute__((ext_vector_type(4)));
typedef float f32x2 __attribute__((ext_vector_type(2)));
typedef unsigned u32x4 __attribute__((ext_vector_type(4)));
typedef unsigned u32x2 __attribute__((ext_vector_type(2)));

constexpr int D = 2048, SEQ = 8192, MP = 16384, MS = 512, M = MP + MS, ZW = 1024, FF = 5632;
constexpr float EPS = 1e-6f;
constexpr size_t MiB = (size_t)1 << 20;
constexpr size_t ZB = (size_t)M * ZW * 2;
constexpr size_t WS_AGGA = 1 * MiB, WS_AGGB = 2 * MiB, WS_HIN = 3 * MiB, WS_DBUF = 4 * MiB, WS_RS = 6 * MiB, WS_SSQ = 8 * MiB, WS_WG = 11 * MiB, WS_US = 12 * MiB;
constexpr size_t WS_Z = 16 * MiB;
constexpr size_t WS_WBR = WS_Z + 12 * ZB;
constexpr size_t WS_WOUT = WS_WBR + 12 * MiB;
constexpr size_t WS_P = WS_WOUT + 8 * MiB;
constexpr size_t WS_KBP = WS_P + ZB;
constexpr size_t WS_VTP = WS_KBP + 1 * MiB;
constexpr size_t WS_KBS = WS_VTP + 1 * MiB;
constexpr size_t WS_VTS = WS_KBS + 8 * MiB;
constexpr size_t WS_WKV = WS_VTS + 8 * MiB;
constexpr size_t WS_MEMN = WS_WKV + 8 * MiB;
constexpr size_t WS_STS = WS_MEMN + 2 * MiB;
constexpr size_t WS_END = WS_STS + 4 * MiB;
constexpr size_t WS_MM = WS_Z + 2 * ZB;
constexpr size_t WS_WUP = WS_Z + 4 * ZB;
constexpr size_t WS_WDN = WS_WUP + 44 * MiB;
constexpr size_t WS_YPRE = WS_Z + 0 * ZB;
constexpr size_t WS_XF = WS_YPRE;
constexpr size_t WS_ACT = WS_Z + 6 * ZB;
constexpr size_t WS_SLAB6 = WS_P;
constexpr size_t WS_SLAB9 = WS_WUP;
constexpr size_t WS_YPRE2 = WS_Z + 2 * ZB;
constexpr size_t WS_R2 = 8 * MiB;
constexpr size_t DO_XN = 0, DO_WIN = 66 * MiB, DO_U = 0, DO_ST = 64 * MiB;
constexpr size_t O_Y = 0, O_MK = (size_t)M * D, O_MV = O_MK + 524288, O_RHP = O_MV + 524288, O_RCP = O_RHP + 2048, O_HGP = O_RCP + 6144, O_FCP = O_HGP + 262144,
                 O_RHS = O_FCP + 22528, O_RCS = O_RHS + 16384, O_HGS = O_RCS + 49152, O_FCS = O_HGS + 2097152, O_END = O_FCS + 180224;

constexpr int LDS_BYTES = 131072 + 1024;
constexpr int NPH = 11;
#define WGM_P1 4
#define WGM_P8 4

__device__ __forceinline__ unsigned f2bf(float f) { unsigned u = __builtin_bit_cast(unsigned, f); return (u + 0x7fffu + ((u >> 16) & 1u)) >> 16; }
__device__ __forceinline__ unsigned pk2(float lo, float hi) { return f2bf(lo) | (f2bf(hi) << 16); }
__device__ __forceinline__ float bf2f(unsigned b) { return __builtin_bit_cast(float, b << 16); }
__device__ __forceinline__ float bflo(unsigned w) { return __builtin_bit_cast(float, w << 16); }
__device__ __forceinline__ float bfhi(unsigned w) { return __builtin_bit_cast(float, w & 0xffff0000u); }
__device__ __forceinline__ float sigm(float x) { return __builtin_amdgcn_rcpf(1.f + __expf(-x)); }
__device__ __forceinline__ float wave_sum(float v) {
#pragma unroll
    for (int o = 1; o < 64; o <<= 1) v += __shfl_xor(v, o);
    return v;
}
__device__ __forceinline__ unsigned cvt_pk_bf16(float lo, float hi) { unsigned r; asm volatile("v_cvt_pk_bf16_f32 %0, %1, %2" : "=v"(r) : "v"(lo), "v"(hi)); return r; }
__device__ __forceinline__ u32x4 pack8(f32x4 a, f32x4 b) { u32x4 w; w.x = cvt_pk_bf16(a[0], a[1]); w.y = cvt_pk_bf16(a[2], a[3]); w.z = cvt_pk_bf16(b[0], b[1]); w.w = cvt_pk_bf16(b[2], b[3]); return w; }
__device__ __forceinline__ void unpack8(u32x4 w, f32x4& a, f32x4& b) { a = (f32x4){bflo(w.x), bfhi(w.x), bflo(w.y), bfhi(w.y)}; b = (f32x4){bflo(w.z), bfhi(w.z), bflo(w.w), bfhi(w.w)}; }

namespace pg8 {
constexpr int BM = 256, BK = 64, HALF = 128, HTB = HALF * BK * 2, STAGE_BYTES = 8 * HTB, NXCD = 8, WGM = 8;
__host__ __device__ __forceinline__ int lds_byte(int r, int c) { const int st = (r >> 4) * 2 + (c >> 5), rr = r & 15, cc = c & 31, ob = rr * 64 + cc * 2; return st * 1024 + (ob ^ (((ob >> 9) & 1) << 5)); }
__host__ __device__ __forceinline__ void stage_rc(int b, int& R, int& C) { const int st = b / 1024, sb = b % 1024, swz = sb ^ (((sb >> 9) & 1) << 5); R = (st >> 1) * 16 + swz / 64; C = (st & 1) * 32 + (swz % 64) / 2; }
__host__ __device__ __forceinline__ int perm32(int rho) { const int n = rho >> 4, i = rho & 15; return 8 * (i >> 2) + 4 * n + (i & 3); }

struct Unit { int pm, pn, aux; };
struct Order {
    int nM, nN, nwg, G, c, rep, wgm;
    __device__ void init(int nM_, int nN_, int G_, int c_, int rep_ = 1, int wgm_ = WGM) { nM = nM_; nN = nN_; nwg = nM * nN; G = G_; c = c_; rep = rep_; wgm = wgm_; }
    __device__ bool next(int i, Unit& u) const {
        const long L = (long)(i / rep) * G + c; if (L >= nwg) return false;
        int wgid = (int)L; { const int q = nwg / NXCD, r = nwg % NXCD, xcd = wgid % NXCD, off = wgid / NXCD; wgid = (xcd < r ? xcd * (q + 1) : r * (q + 1) + (xcd - r) * q) + off; }
        const int nig = wgm * nN, gid = wgid / nig, fm = gid * wgm, gsz = (nM - fm) < wgm ? (nM - fm) : wgm;
        u.pm = fm + ((wgid % nig) % gsz); u.pn = (wgid % nig) / gsz; u.aux = i % rep; return true;
    }
};

struct MergeOrder {
    int nM, nN, nwg, G, c, wgm;
    __device__ void init(int nM_, int nN_, int G_, int c_, int wgm_) { nM = nM_; nN = nN_; nwg = nM * nN; G = G_; c = c_; wgm = wgm_; }
    __device__ void tile(long L, Unit& u) const {
        int wgid = (int)L; { const int q = nwg / NXCD, r = nwg % NXCD, xcd = wgid % NXCD, off = wgid / NXCD; wgid = (xcd < r ? xcd * (q + 1) : r * (q + 1) + (xcd - r) * q) + off; }
        const int nig = wgm * nN, gid = wgid / nig, fm = gid * wgm, gsz = (nM - fm) < wgm ? (nM - fm) : wgm;
        u.pm = fm + ((wgid % nig) % gsz); u.pn = (wgid % nig) / gsz;
    }
    __device__ bool next(int i, Unit& u) const {
        if (G != 256 || nwg != 528) { const long L = (long)(i / 3) * G + c; if (L >= nwg) return false; tile(L, u); u.aux = i % 3; return true; }
        int k = i;
        if (c < 16) { if (k == 0) { tile(512 + c, u); u.aux = 0 | ((c + 1) << 2); return true; } k -= 1; }
        else if (c < 32) { if (k == 3) { tile(512 + c - 16, u); u.aux = 1 | ((c - 16 + 1) << 2); return true; } if (k > 3) k -= 1; }
        else if (c < 48) { if (k == 6) { tile(512 + c - 32, u); u.aux = 2 | ((c - 32 + 1) << 2); return true; } }
        if (k >= 6) return false;
        tile((long)(k / 3) * G + c, u); u.aux = k % 3; return true;
    }
};

template <class Epi, class Op, class Sched = Order>
__device__ __forceinline__ void gemm_phase(LAS unsigned char* lds, const Op& op, const Sched& S, const Epi& E) {
    const int tid = threadIdx.x, wid = __builtin_amdgcn_readfirstlane(tid >> 6), lane = tid & 63, wr = wid >> 2, wc = wid & 3, fr = lane & 15, fq = lane >> 4;
    const int K = op.K, nt = K / BK;
    unsigned voffA[2], voffB[2];
#pragma unroll
    for (int i = 0; i < 2; ++i) { int R, C; stage_rc(tid * 16 + i * 8192, R, C); const int Rb = Epi::PERM ? ((R & ~31) + perm32(R & 31)) : R;
        const int Ra = Op::SEG ? ((R & 15) * 8 + ((R >> 4) & 3)) : R;
        voffA[i] = (unsigned)(Ra * op.lda + C) * 2u; voffB[i] = (unsigned)(Rb * op.ldb + C) * 2u; }
    const size_t kstep = (size_t)(BK * 2);
    const size_t hstepA = op.hstepA();
    const size_t hstepB = (size_t)HALF * op.ldb * 2;
    const unsigned ldsw = (unsigned)wid * 1024u;
    const int aoff = lds_byte(wr * 64 + fr, fq * 8), boff = lds_byte(wc * 32 + fr, fq * 8);
#define PG8_SA(b, h) (((b) * 2 + (h)) * HTB)
#define PG8_SB(b, h) ((4 + (b) * 2 + (h)) * HTB)
#define PG8_STAGEB(bufoff, gbase) do { _Pragma("unroll") for (int _i = 0; _i < 2; ++_i) \
        __builtin_amdgcn_global_load_lds((const unsigned*)((const char*)(gbase) + voffB[_i]), (LAS unsigned*)(lds + (bufoff) + ldsw + _i * 8192), 16, 0, 0); } while (0)
#define PG8_STAGEA(bufoff, gbase, dlt) do { \
        __builtin_amdgcn_global_load_lds((const unsigned*)((const char*)(gbase) + voffA[0]), (LAS unsigned*)(lds + (bufoff) + ldsw), 16, 0, 0); \
        __builtin_amdgcn_global_load_lds((const unsigned*)((const char*)(gbase) + (dlt) + voffA[1]), (LAS unsigned*)(lds + (bufoff) + ldsw + 8192), 16, 0, 0); } while (0)
#define PG8_LDA(dst, b, h) do { _Pragma("unroll") for (int m = 0; m < 4; ++m) _Pragma("unroll") for (int k = 0; k < 2; ++k) dst[m][k] = *(const LAS bf16x8*)(lds + PG8_SA(b, h) + aoff + m * 2048 + k * 1024); } while (0)
#define PG8_LDB(dst, b, h) do { _Pragma("unroll") for (int n = 0; n < 2; ++n) _Pragma("unroll") for (int k = 0; k < 2; ++k) dst[n][k] = *(const LAS bf16x8*)(lds + PG8_SB(b, h) + boff + n * 2048 + k * 1024); } while (0)
#define PG8_MMA(ai, bj, At, Bt) do { __builtin_amdgcn_s_setprio(1); _Pragma("unroll") for (int m = 0; m < 4; ++m) _Pragma("unroll") for (int n = 0; n < 2; ++n) _Pragma("unroll") for (int k = 0; k < 2; ++k) \
        acc[ai][bj][m][n] = __builtin_amdgcn_mfma_f32_16x16x32_bf16(Bt[n][k], At[m][k], acc[ai][bj][m][n], 0, 0, 0); __builtin_amdgcn_s_setprio(0); } while (0)
#define PG8_WAIT_V(n) asm volatile("s_waitcnt vmcnt(" #n ")" ::: "memory")
#define PG8_WAIT_L(n) asm volatile("s_waitcnt lgkmcnt(" #n ")" ::: "memory")
#define PG8_BAR __builtin_amdgcn_s_barrier()
#define PG8_SCHED __builtin_amdgcn_sched_barrier(0)
    Unit cur, nxt; int ui = 0;
    if (!S.next(0, cur)) return;
    f32x4 acc[2][2][4][2];
#pragma unroll
    for (int a = 0; a < 2; ++a)
#pragma unroll
        for (int b = 0; b < 2; ++b)
#pragma unroll
            for (int m = 0; m < 4; ++m)
#pragma unroll
                for (int n = 0; n < 2; ++n) acc[a][b][m][n] = (f32x4){0.f, 0.f, 0.f, 0.f};
    bf16x8 At[4][2], B0[2][2], B1[2][2];
    const char* cA = op.a_base(cur, 0); const char* cB = op.b_base(cur);
    long dAc = Op::SEG ? (long)(op.a_base(cur, 1) - cA) : 0;
    PG8_STAGEB(PG8_SB(0, 0), cB); PG8_STAGEB(PG8_SB(0, 1), cB + hstepB); PG8_STAGEA(PG8_SA(0, 0), cA, dAc); PG8_STAGEA(PG8_SA(0, 1), cA + hstepA, dAc);
    if (wr == 1) PG8_BAR;
    PG8_WAIT_V(2); PG8_BAR;
    PG8_STAGEB(PG8_SB(1, 0), cB + kstep); PG8_STAGEA(PG8_SA(1, 0), cA + kstep, dAc); PG8_STAGEB(PG8_SB(1, 1), cB + hstepB + kstep);
    PG8_WAIT_V(6); PG8_BAR;
    for (;;) {
        const bool has_next = S.next(ui + 1, nxt);
        const char* nA = has_next ? op.a_base(nxt, 0) : cA; const char* nB = has_next ? op.b_base(nxt) : cB;
        const long dAn = Op::SEG ? (has_next ? (long)(op.a_base(nxt, 1) - nA) : dAc) : 0;
        for (int t = 0; t < nt; t += 2) {
            const bool last = (t == nt - 2);
            const char* a1 = cA + (size_t)(t + 1) * kstep;
            const char* a2 = last ? nA : cA + (size_t)(t + 2) * kstep; const char* b2 = last ? nB : cB + (size_t)(t + 2) * kstep;
            const long d2 = last ? dAn : dAc;
            const char* a3 = a2 + kstep; const char* b3 = b2 + kstep;
            PG8_LDB(B0, 0, 0); PG8_LDB(B1, 0, 1); PG8_SCHED; PG8_LDA(At, 0, 0); PG8_STAGEA(PG8_SA(1, 1), a1 + hstepA, dAc);
            PG8_WAIT_V(8); PG8_WAIT_L(0); PG8_BAR; PG8_MMA(0, 0, At, B0); PG8_MMA(0, 1, At, B1); PG8_BAR; PG8_SCHED;
            PG8_LDA(At, 0, 1); PG8_STAGEB(PG8_SB(0, 0), b2); PG8_STAGEB(PG8_SB(0, 1), b2 + hstepB); PG8_STAGEA(PG8_SA(0, 0), a2, d2);
            PG8_WAIT_V(8); PG8_WAIT_L(0); PG8_BAR; PG8_MMA(1, 0, At, B0); PG8_MMA(1, 1, At, B1); PG8_BAR; PG8_SCHED;
            PG8_LDB(B0, 1, 0); PG8_LDB(B1, 1, 1); PG8_SCHED; PG8_LDA(At, 1, 0); PG8_STAGEA(PG8_SA(0, 1), a2 + hstepA, d2);
            PG8_WAIT_V(8); PG8_WAIT_L(0); PG8_BAR; PG8_MMA(0, 0, At, B0); PG8_MMA(0, 1, At, B1); PG8_BAR; PG8_SCHED;
            PG8_LDA(At, 1, 1); PG8_STAGEB(PG8_SB(1, 0), b3); PG8_STAGEB(PG8_SB(1, 1), b3 + hstepB); PG8_STAGEA(PG8_SA(1, 0), a3, d2);
            PG8_WAIT_V(8); PG8_WAIT_L(0); PG8_BAR; PG8_MMA(1, 0, At, B0); PG8_MMA(1, 1, At, B1); PG8_BAR; PG8_SCHED;
        }
        if (wr == 0) PG8_BAR;
        E(acc, cur, wr, wc, fr, fq);
        if (!has_next) break;
#pragma unroll
        for (int a = 0; a < 2; ++a)
#pragma unroll
            for (int b = 0; b < 2; ++b)
#pragma unroll
                for (int m = 0; m < 4; ++m)
#pragma unroll
                    for (int n = 0; n < 2; ++n) acc[a][b][m][n] = (f32x4){0.f, 0.f, 0.f, 0.f};
        cur = nxt; cA = nA; cB = nB; dAc = dAn; ++ui;
        if (wr == 1) PG8_BAR;
    }
    PG8_WAIT_V(0);
    PG8_BAR;
#undef PG8_SA
#undef PG8_SB
#undef PG8_STAGEA
#undef PG8_STAGEB
#undef PG8_LDA
#undef PG8_LDB
#undef PG8_MMA
#undef PG8_WAIT_V
#undef PG8_WAIT_L
#undef PG8_BAR
#undef PG8_SCHED
}
}
using pg8::Unit; using pg8::Order;

struct OpPlain {
    static constexpr bool SEG = false;
    const bf16_t* A; const bf16_t* Bt; int K, lda, ldb;
    __device__ __forceinline__ const char* a_base(const Unit& u, int) const { return (const char*)(A + (size_t)u.pm * 256 * lda); }
    __device__ __forceinline__ const char* b_base(const Unit& u) const { return (const char*)(Bt + (size_t)u.pn * 256 * ldb); }
    __device__ __forceinline__ size_t hstepA() const { return (size_t)128 * lda * 2; }
};
struct OpMerge {
    static constexpr bool SEG = false;
    const bf16_t* ya; const bf16_t* yb; const bf16_t* yc; const bf16_t* Wt; int K, lda, ldb;
    __device__ __forceinline__ const char* a_base(const Unit& u, int) const { const int nb = u.aux & 3; const bf16_t* A = nb == 0 ? ya : (nb == 1 ? yb : yc); return (const char*)(A + (size_t)u.pm * 256 * 1024); }
    __device__ __forceinline__ const char* b_base(const Unit& u) const { return (const char*)(Wt + ((size_t)(u.aux & 3) * 2048 + (size_t)u.pn * 256) * 1024); }
    __device__ __forceinline__ size_t hstepA() const { return (size_t)128 * 1024 * 2; }
};
__device__ __forceinline__ void attn_decode(int id, int& row0, int& head, int& kvb, int& nvalid) {
    if (id < 256) { const int tile = id >> 2; head = id & 3; row0 = tile * 256; kvb = tile >> 5; nvalid = 256; }
    else { const int j = id - 256; head = j & 3; const int sb = j >> 2; row0 = MP + 32 * sb; kvb = 2 + sb; nvalid = 32; }
}
struct OpAttn {
    static constexpr bool SEG = false;
    const bf16_t* Abuf; const bf16_t* Bp; const bf16_t* Bs; int K, lda, ldb; int pv;
    __device__ __forceinline__ const char* a_base(const Unit& u, int) const { int row0, head, kvb, nv; attn_decode(u.pm, row0, head, kvb, nv); return (const char*)(Abuf + (size_t)row0 * 1024 + head * 256); }
    __device__ __forceinline__ const char* b_base(const Unit& u) const { int row0, head, kvb, nv; attn_decode(u.pm, row0, head, kvb, nv);
        const bf16_t* base = kvb < 2 ? Bp + (size_t)kvb * 262144 : Bs + (size_t)(kvb - 2) * 262144;
        return (const char*)(pv ? base + (size_t)head * 256 * 256 : base + head * 256); }
    __device__ __forceinline__ size_t hstepA() const { return (size_t)128 * 1024 * 2; }
};
__device__ __forceinline__ int seg_base_row(int g) { if (g < 132) { const int b = g / 66, gi = g - 66 * b; return b * SEQ + 126 * gi - 2; } return MP + 128 * (g - 132); }
struct OpUp {
    static constexpr bool SEG = true;
    const bf16_t* A; const bf16_t* Bt; int K, lda, ldb;
    __device__ __forceinline__ const char* a_base(const Unit& u, int piece) const { return (const char*)(A + (long)seg_base_row(2 * u.pm + piece) * lda); }
    __device__ __forceinline__ const char* b_base(const Unit& u) const { return (const char*)(Bt + (size_t)u.pn * 256 * ldb); }
    __device__ __forceinline__ size_t hstepA() const { return (size_t)4 * lda * 2; }
};

typedef f32x4 Acc[2][2][4][2];

struct EpiZ {
    static constexpr bool PERM = true;
    bf16_t* Z;
    __device__ __forceinline__ void operator()(const Acc& acc, const Unit& u, int wr, int wc, int fr, int fq) const {
        const int seg = u.pn >> 2, col0 = (u.pn & 3) * 256 + wc * 32 + 8 * fq; const int row0 = u.pm * 256 + wr * 64 + fr;
        bf16_t* base = Z + (size_t)seg * ((size_t)M * ZW);
#pragma unroll
        for (int ai = 0; ai < 2; ++ai)
#pragma unroll
            for (int m = 0; m < 4; ++m) { bf16_t* rowp = base + (size_t)(row0 + ai * 128 + m * 16) * ZW + col0;
#pragma unroll
                for (int bj = 0; bj < 2; ++bj) *(u32x4*)(rowp + bj * 128) = pack8(acc[ai][bj][m][0], acc[ai][bj][m][1]); }
    }
};
struct EpiKV {
    static constexpr bool PERM = true;
    float* out; bf16_t* kb;
    __device__ __forceinline__ void operator()(const Acc& acc, const Unit& u, int wr, int wc, int fr, int fq) const {
        const bool isv = u.pn >= 4; const int col0 = (u.pn & 3) * 256 + wc * 32 + 8 * fq; const int row0 = u.pm * 256 + wr * 64 + fr;
        float* ob = out + (isv ? O_MV : O_MK);
#pragma unroll
        for (int ai = 0; ai < 2; ++ai)
#pragma unroll
            for (int m = 0; m < 4; ++m) { const size_t ro = (size_t)(row0 + ai * 128 + m * 16) * 1024 + col0;
#pragma unroll
                for (int bj = 0; bj < 2; ++bj) { *(f32x4*)(ob + ro + bj * 128) = acc[ai][bj][m][0]; *(f32x4*)(ob + ro + bj * 128 + 4) = acc[ai][bj][m][1];
                    if (!isv) *(u32x4*)(kb + ro + bj * 128) = pack8(acc[ai][bj][m][0], acc[ai][bj][m][1]); } }
    }
};
struct EpiS {
    static constexpr bool PERM = true;
    bf16_t* P; float* rs;
    __device__ __forceinline__ void operator()(const Acc& acc, const Unit& u, int wr, int wc, int fr, int fq) const {
        int row0, head, kvb, nv; attn_decode(u.pm, row0, head, kvb, nv);
#pragma unroll
        for (int ai = 0; ai < 2; ++ai)
#pragma unroll
            for (int m = 0; m < 4; ++m) { const int rt = ai * 128 + wr * 64 + m * 16 + fr; float s = 0.f; u32x4 w[2];
#pragma unroll
                for (int bj = 0; bj < 2; ++bj) { f32x4 p0, p1;
#pragma unroll
                    for (int j = 0; j < 4; ++j) { p0[j] = __expf(acc[ai][bj][m][0][j] * 0.0625f); p1[j] = __expf(acc[ai][bj][m][1][j] * 0.0625f); }
                    s += (p0[0] + p0[1]) + (p0[2] + p0[3]) + (p1[0] + p1[1]) + (p1[2] + p1[3]); w[bj] = pack8(p0, p1); }
                s += __shfl_xor(s, 16); s += __shfl_xor(s, 32);
                if (rt < nv) { bf16_t* rowp = P + (size_t)(row0 + rt) * 1024 + head * 256 + wc * 32 + 8 * fq;
                    *(u32x4*)rowp = w[0]; *(u32x4*)(rowp + 128) = w[1];
                    if (fq == 0) rs[(size_t)(row0 + rt) * 16 + head * 4 + wc] = s; } }
    }
};
struct EpiPV {
    static constexpr bool PERM = true;
    bf16_t* Y; const float* rs;
    __device__ __forceinline__ void operator()(const Acc& acc, const Unit& u, int wr, int wc, int fr, int fq) const {
        int row0, head, kvb, nv; attn_decode(u.pm, row0, head, kvb, nv);
#pragma unroll
        for (int ai = 0; ai < 2; ++ai)
#pragma unroll
            for (int m = 0; m < 4; ++m) { const int rt = ai * 128 + wr * 64 + m * 16 + fr;
                if (rt < nv) { const f32x4 r4 = *(const f32x4*)(rs + (size_t)(row0 + rt) * 16 + head * 4); const float inv = 1.f / ((r4[0] + r4[1]) + (r4[2] + r4[3]));
                    bf16_t* rowp = Y + (size_t)(row0 + rt) * 1024 + head * 256 + wc * 32 + 8 * fq;
#pragma unroll
                    for (int bj = 0; bj < 2; ++bj) *(u32x4*)(rowp + bj * 128) = pack8(acc[ai][bj][m][0] * inv, acc[ai][bj][m][1] * inv); } }
    }
};
struct EpiMerge {
    static constexpr bool PERM = true;
    const bf16_t* Zg; const float* bgate; bf16_t* MM; unsigned* flags;
    __device__ __forceinline__ void operator()(const Acc& acc, const Unit& u, int wr, int wc, int fr, int fq) const {
        const int nb = u.aux & 3, xj = (u.aux >> 2) - 1;
        if (xj >= 0 && nb > 0) {
            unsigned sp = 0; while (__hip_atomic_load(flags + 64 * xj, __ATOMIC_RELAXED, __HIP_MEMORY_SCOPE_AGENT) < 8u * (unsigned)nb) { __builtin_amdgcn_s_sleep(2); if (++sp > (1u << 22)) break; }
            __builtin_amdgcn_fence(__ATOMIC_ACQUIRE, "agent"); } const bf16_t* gb = Zg + (size_t)(2 * nb + (u.pn >> 2)) * ((size_t)M * ZW);
        const int gcol = (u.pn & 3) * 256 + wc * 32 + 8 * fq, ocol = u.pn * 256 + wc * 32 + 8 * fq; const int row0 = u.pm * 256 + wr * 64 + fr;
        f32x4 bg[2][2];
#pragma unroll
        for (int bj = 0; bj < 2; ++bj) { bg[bj][0] = *(const f32x4*)(bgate + nb * 2048 + ocol + bj * 128); bg[bj][1] = *(const f32x4*)(bgate + nb * 2048 + ocol + bj * 128 + 4); }
#pragma unroll
        for (int am = 0; am < 4; ++am) { const int ai = am >> 1, mb = (am & 1) * 2;
            u32x4 gw[2][2], pw[2][2];
#pragma unroll
            for (int mm = 0; mm < 2; ++mm)
#pragma unroll
                for (int bj = 0; bj < 2; ++bj) { const size_t row = (size_t)(row0 + ai * 128 + (mb + mm) * 16);
                    gw[mm][bj] = *(const u32x4*)(gb + row * ZW + gcol + bj * 128);
                    pw[mm][bj] = nb > 0 ? *(const u32x4*)(MM + row * D + ocol + bj * 128) : (u32x4){0u, 0u, 0u, 0u}; }
#pragma unroll
            for (int mm = 0; mm < 2; ++mm)
#pragma unroll
                for (int bj = 0; bj < 2; ++bj) { const int m = mb + mm; const size_t row = (size_t)(row0 + ai * 128 + m * 16);
                    f32x4 g0, g1, p0, p1; unpack8(gw[mm][bj], g0, g1); unpack8(pw[mm][bj], p0, p1);
#pragma unroll
                    for (int j = 0; j < 4; ++j) { p0[j] += sigm(g0[j] + bg[bj][0][j]) * acc[ai][bj][m][0][j]; p1[j] += sigm(g1[j] + bg[bj][1][j]) * acc[ai][bj][m][1][j]; }
                    *(u32x4*)(MM + row * D + ocol + bj * 128) = pack8(p0, p1); }
        }
        if (xj >= 0 && nb < 2) {
            __builtin_amdgcn_fence(__ATOMIC_RELEASE, "agent"); asm volatile("s_waitcnt vmcnt(0)" ::: "memory");
            if (fr == 0 && fq == 0) __hip_atomic_fetch_add(flags + 64 * xj, 1u, __ATOMIC_RELAXED, __HIP_MEMORY_SCOPE_AGENT); }
    }
};
struct EpiPre {
    static constexpr bool PERM = true;
    bf16_t* Y;
    __device__ __forceinline__ void operator()(const Acc& acc, const Unit& u, int wr, int wc, int fr, int fq) const {
        const int ocol = u.pn * 256 + wc * 32 + 8 * fq; const int row0 = u.pm * 256 + wr * 64 + fr;
#pragma unroll
        for (int ai = 0; ai < 2; ++ai)
#pragma unroll
            for (int m = 0; m < 4; ++m) { const size_t row = (size_t)(row0 + ai * 128 + m * 16);
#pragma unroll
                for (int bj = 0; bj < 2; ++bj) *(u32x4*)(Y + row * D + ocol + bj * 128) = pack8(acc[ai][bj][m][0], acc[ai][bj][m][1]); }
    }
};
struct OpSplit {
    static constexpr bool SEG = false;
    const bf16_t* A; const bf16_t* Bt; int K, lda, ldb;
    __device__ __forceinline__ const char* a_base(const Unit& u, int) const { return (const char*)(A + (size_t)(MP + 256 * (u.pm & 1)) * lda + (size_t)(u.pm >> 1) * K); }
    __device__ __forceinline__ const char* b_base(const Unit& u) const { return (const char*)(Bt + (size_t)u.pn * 256 * ldb + (size_t)(u.pm >> 1) * K); }
    __device__ __forceinline__ size_t hstepA() const { return (size_t)128 * lda * 2; }
};
struct EpiSlab {
    static constexpr bool PERM = true;
    float* slab;
    __device__ __forceinline__ void operator()(const Acc& acc, const Unit& u, int wr, int wc, int fr, int fq) const {
        const int ocol = u.pn * 256 + wc * 32 + 8 * fq; const int row0 = (u.pm >> 1) * 512 + (u.pm & 1) * 256 + wr * 64 + fr;
#pragma unroll
        for (int ai = 0; ai < 2; ++ai)
#pragma unroll
            for (int m = 0; m < 4; ++m) { float* rp = slab + (size_t)(row0 + ai * 128 + m * 16) * D + ocol;
#pragma unroll
                for (int bj = 0; bj < 2; ++bj) { *(f32x4*)(rp + bj * 128) = acc[ai][bj][m][0]; *(f32x4*)(rp + bj * 128 + 4) = acc[ai][bj][m][1]; } }
    }
};
__device__ __forceinline__ float gelu_tanh(float x) { const float y = 1.5957691216f * (x + 0.044715f * x * x * x); return x * __builtin_amdgcn_rcpf(1.f + __expf(-y)); }
__device__ __forceinline__ f32x2 gelu_mul_pk(f32x2 c, f32x2 v) {
    const f32x2 c2 = c * c; const f32x2 t = c * (c2 * (-0.10294324f) + (-2.3022082f));
    f32x2 e; e.x = __builtin_amdgcn_exp2f(t.x); e.y = __builtin_amdgcn_exp2f(t.y);
    const f32x2 d = e + 1.0f; f32x2 r; r.x = __builtin_amdgcn_rcpf(d.x); r.y = __builtin_amdgcn_rcpf(d.y);
    return (c * v) * r;
}
struct EpiUp {
    static constexpr bool PERM = true;
    bf16_t* act; const float* cw; const float* cb; const float* st; float* out; const float* r2;
    __device__ __forceinline__ void operator()(const Acc& acc, const Unit& u, int wr, int wc, int fr, int fq) const {
        const int g = 2 * u.pm + wr; const int col = u.pn * 128 + wc * 32 + 8 * fq;
        const bool smp = g >= 132; const int b = smp ? 0 : g / 66, gi = g - 66 * b; const int s0 = 126 * gi - 2;
        f32x4 w0[2], w1[2], w2[2], bb[2];
#pragma unroll
        for (int n = 0; n < 2; ++n) { w0[n] = *(const f32x4*)(cw + col + 4 * n); w1[n] = *(const f32x4*)(cw + FF + col + 4 * n); w2[n] = *(const f32x4*)(cw + 2 * FF + col + 4 * n); bb[n] = *(const f32x4*)(cb + col + 4 * n); }
        float rr[8];
#pragma unroll
        for (int e = 0; e < 8; ++e) { const int idx = fr * 8 + e; int row = smp ? MP + 128 * (g - 132) + idx : b * SEQ + s0 + idx; row = row < 0 ? 0 : row; rr[e] = r2[row]; }
#pragma unroll
        for (int n = 0; n < 2; ++n) {
            f32x4 um2, um1;
#pragma unroll
            for (int j = 0; j < 4; ++j) { um2[j] = __shfl_up(acc[1][0][2][n][j] * rr[6], 1); um1[j] = __shfl_up(acc[1][0][3][n][j] * rr[7], 1); }
            if (smp) { if ((fr & 3) == 0) { const int sb = 4 * (g - 132) + (fr >> 2); um2 = *(const f32x4*)(st + (size_t)(sb * 2 + 0) * FF + col + 4 * n); um1 = *(const f32x4*)(st + (size_t)(sb * 2 + 1) * FF + col + 4 * n); } }
#pragma unroll
            for (int e = 0; e < 8; ++e) { const int ai = e >> 2, m = e & 3; f32x4 uu = acc[ai][0][m][n] * rr[e]; const f32x4 vv = acc[ai][1][m][n] * rr[e];
                const int idx = fr * 8 + e; bool valid; size_t row;
                if (smp) { valid = true; row = (size_t)(MP + 128 * (g - 132) + idx); }
                else { const int tm = s0 + idx; if (tm < 0) uu = (f32x4){0.f, 0.f, 0.f, 0.f}; valid = (idx >= 2) && (tm < SEQ); row = (size_t)(b * SEQ + tm); }
                f32x4 c = bb[n] + w0[n] * um2 + w1[n] * um1 + w2[n] * uu;
                const f32x2 a01 = gelu_mul_pk((f32x2){c[0], c[1]}, (f32x2){vv[0], vv[1]}), a23 = gelu_mul_pk((f32x2){c[2], c[3]}, (f32x2){vv[2], vv[3]});
                const f32x4 a = (f32x4){a01.x, a01.y, a23.x, a23.y};
                if (valid) { u32x2 w; w.x = cvt_pk_bf16(a[0], a[1]); w.y = cvt_pk_bf16(a[2], a[3]); *(u32x2*)(act + row * FF + col + 4 * n) = w;
                    if (smp) { const int tau = idx & 31; if (tau >= 30) *(f32x4*)(out + O_FCS + (size_t)((4 * (g - 132) + (idx >> 5)) * 2 + (tau - 30)) * FF + col + 4 * n) = uu; }
                    else { const int tm = s0 + idx; if (tm >= SEQ - 2) *(f32x4*)(out + O_FCP + (size_t)(b * 2 + (tm - (SEQ - 2))) * FF + col + 4 * n) = uu; } }
                um2 = um1; um1 = uu; }
        }
    }
};

struct Ctx { LAS unsigned char* lds; int tid, lane, wave, G, bid; const float* const* in; float* out; unsigned char* ws; };

__device__ __forceinline__ void transpose_item(const float* W, int ldw, bf16_t* WT, int ldt, int k0, int n0, int drow0, LAS float* scr, int lane, const float* rscale = nullptr) {
    float tv[32];
#pragma unroll
    for (int i = 0; i < 32; ++i) { const int kk = 2 * i + (lane >> 5); tv[i] = __builtin_nontemporal_load(&W[(size_t)(k0 + kk) * ldw + n0 + (lane & 31)]); }
    if (rscale) {
#pragma unroll
        for (int i = 0; i < 32; ++i) tv[i] *= rscale[k0 + 2 * i + (lane >> 5)]; }
#pragma unroll
    for (int i = 0; i < 32; ++i) { const int kk = 2 * i + (lane >> 5); scr[kk * 33 + (lane & 31)] = tv[i]; }
    asm volatile("s_waitcnt lgkmcnt(0)" ::: "memory");
    const int c = lane & 7;
#pragma unroll
    for (int j = 0; j < 4; ++j) { const int n = (lane >> 3) + 8 * j; const LAS float* s = scr + (8 * c) * 33 + n;
        u32x4 o; o.x = pk2(s[0 * 33], s[1 * 33]); o.y = pk2(s[2 * 33], s[3 * 33]); o.z = pk2(s[4 * 33], s[5 * 33]); o.w = pk2(s[6 * 33], s[7 * 33]);
        *(u32x4*)(WT + (size_t)(drow0 + n) * ldt + k0 + 8 * c) = o; }
    asm volatile("s_waitcnt lgkmcnt(0)" ::: "memory");
}
template <class F> __device__ __forceinline__ void transpose_job(const float* W, int K, int N, bf16_t* WT, int ldt, int r, LAS float* scr, int lane, F dmap, const float* rscale = nullptr) {
    const int nblk = N / 32, kb = r / nblk, nb = r % nblk; transpose_item(W, N, WT, ldt, 64 * kb, 32 * nb, dmap(32 * nb), scr, lane, rscale);
}
__device__ __forceinline__ const float* xrow_ptr(const Ctx& c, int m) { return m < MP ? c.in[0] + (size_t)m * D : c.in[1] + (size_t)(m - MP) * D; }
__device__ __forceinline__ void rms_row_bf16(const float* xrow, const float* g, bf16_t* orow, int lane) {
    const f32x4* xr = (const f32x4*)xrow + lane; f32x4 v[8]; float s = 0.f;
#pragma unroll
    for (int j = 0; j < 8; ++j) { v[j] = __builtin_nontemporal_load(&xr[64 * j]); s += (v[j][0] * v[j][0] + v[j][1] * v[j][1]) + (v[j][2] * v[j][2] + v[j][3] * v[j][3]); }
    const float rs = rsqrtf(wave_sum(s) * (1.f / D) + EPS);
    u32x2* o = (u32x2*)orow + lane;
#pragma unroll
    for (int j = 0; j < 8; ++j) { const f32x4 gg = ((const f32x4*)g)[lane + 64 * j]; u32x2 w; w.x = pk2(v[j][0] * rs * gg[0], v[j][1] * rs * gg[1]); w.y = pk2(v[j][2] * rs * gg[2], v[j][3] * rs * gg[3]); o[64 * j] = w; }
}

__device__ __forceinline__ void prep_late(const Ctx& c, int wv, int nwv) {
    LAS float* scr = (LAS float*)(c.lds + c.wave * 16384);
    constexpr int I_BR = 16 * 64, I_OUT = 32 * 64, I_VS = 4 * 32, I_HG = 2 * 4;
    constexpr int NIT = 3 * I_BR + I_OUT + 16 * I_VS + 128 * I_HG;
    for (int it = wv; it < NIT; it += nwv) {
        int r = it;
        if (r < 3 * I_BR) { const int nb = r / I_BR; transpose_job(c.in[22] + (size_t)nb * 1024 * 2048, 1024, 2048, (bf16_t*)(c.ws + WS_WBR) + (size_t)nb * 2048 * 1024, 1024, r % I_BR, scr, c.lane, [](int n0) { return n0; }); continue; } r -= 3 * I_BR;
        if (r < I_OUT) { transpose_job(c.in[24], 2048, 2048, (bf16_t*)(c.ws + WS_WOUT), 2048, r, scr, c.lane, [](int n0) { return n0; }); continue; } r -= I_OUT;
        if (r < 16 * I_VS) { const int b = r / I_VS; transpose_job(c.in[3] + (size_t)b * 262144, 256, 1024, (bf16_t*)(c.ws + WS_VTS) + (size_t)b * 262144, 256, r % I_VS, scr, c.lane, [](int n0) { return n0; }); continue; } r -= 16 * I_VS;
        { const int sq = r / I_HG; transpose_job(c.in[6] + (size_t)sq * 16384, 128, 128, (bf16_t*)(c.ws + WS_STS) + (size_t)sq * 16384, 128, r % I_HG, scr, c.lane, [](int n0) { return n0; }); }
    }
}
__device__ __forceinline__ void phase_prep(const Ctx& c) {
    LAS float* scr = (LAS float*)(c.lds + c.wave * 16384);
    const int gw = c.bid * 8 + c.wave, NGW = c.G * 8;
    bf16_t* win_t = (bf16_t*)((unsigned char*)c.out + DO_WIN);
    constexpr int I_IN = 32 * 384, I_KV = 32 * 64, I_G = 2;
    constexpr int NIT = I_IN + I_KV + 32 * I_G;
    for (int it = gw; it < NIT; it += NGW) {
        int r = it;
        if (r < I_IN) { transpose_job(c.in[10], 2048, 12288, win_t, 2048, r, scr, c.lane, [](int n0) { if (n0 >= 6144) return n0; const int seg = n0 >> 10; const int ps = seg <= 3 ? seg + 2 : seg - 4; return ps * 1024 + (n0 & 1023); }); continue; } r -= I_IN;
        if (r < I_KV) { transpose_job(c.in[21], 2048, 2048, (bf16_t*)(c.ws + WS_WKV), 2048, r, scr, c.lane, [](int n0) { return n0; }); continue; } r -= I_KV;
        { const int h = r / (2 * I_G), which = (r / I_G) & 1, rr = r % I_G;
          transpose_job(c.in[which ? 15 : 13] + (size_t)h * 4096, 64, 64, (bf16_t*)(c.ws + WS_WG) + (size_t)h * 8192 + which * 4096, 64, rr, scr, c.lane, [](int n0) { return n0; }); }
    }
    bf16_t* xn = (bf16_t*)((unsigned char*)c.out + DO_XN);
    for (int m = gw; m < M + 512; m += NGW) {
        if (m < M) rms_row_bf16(xrow_ptr(c, m), c.in[9], xn + (size_t)m * D, c.lane);
        else rms_row_bf16(c.in[8] + (size_t)(m - M) * D, c.in[20], (bf16_t*)(c.ws + WS_MEMN) + (size_t)(m - M) * D, c.lane);
    }
    { const f32x4* src = (const f32x4*)c.in[2]; u32x2* dst = (u32x2*)(c.ws + WS_KBS); const int n4 = 16 * 256 * 1024 / 4;
      for (int i0 = c.bid * 512 + c.tid; i0 < n4; i0 += 4 * c.G * 512) { f32x4 v[4];
#pragma unroll
          for (int q = 0; q < 4; ++q) { const int i = i0 + q * c.G * 512; v[q] = i < n4 ? src[i] : (f32x4){0.f, 0.f, 0.f, 0.f}; }
#pragma unroll
          for (int q = 0; q < 4; ++q) { const int i = i0 + q * c.G * 512; if (i < n4) { u32x2 w; w.x = pk2(v[q][0], v[q][1]); w.y = pk2(v[q][2], v[q][3]); dst[i] = w; } } } }
}

__device__ __forceinline__ void lru_item(const Ctx& c, int cidx, int h, int mode, LAS unsigned char* wl) {
    int lane = c.lane; asm volatile("" : "+v"(lane));
    const int fr = lane & 15, fq = lane >> 4;
    const bool smp = cidx >= 256; const int sb = cidx - 256; const int cb = cidx >> 7, cc = cidx & 127;
    const int row0 = smp ? MP + 32 * sb : cb * SEQ + 64 * cc; const int len = smp ? 32 : 64;
    const bf16_t* zr = (const bf16_t*)(c.ws + WS_Z + 2 * ZB);
    LAS bf16_t* xt = (LAS bf16_t*)wl;
    { u32x4 v[9];
#pragma unroll
      for (int i = 0; i < 9; ++i) { const int ci = lane + 64 * i, r = ci >> 3, c8 = ci & 7; v[i] = (u32x4){0u, 0u, 0u, 0u};
          const bool halo_special = r < 3 && (smp || cc == 0);
          if (r < len + 3 && !halo_special) v[i] = *(const u32x4*)(zr + (size_t)(row0 - 3 + r) * ZW + 64 * h + 8 * c8);
          if (r < 3 && smp) { const float* st = c.in[5] + (size_t)(sb * 3 + r) * 1024 + 64 * h + 8 * c8; const f32x4 a = *(const f32x4*)st, b = *(const f32x4*)(st + 4); v[i] = (u32x4){pk2(a[0], a[1]), pk2(a[2], a[3]), pk2(b[0], b[1]), pk2(b[2], b[3])}; } }
#pragma unroll
      for (int i = 0; i < 9; ++i) { const int ci = lane + 64 * i, r = ci >> 3, c8 = ci & 7; if (r < 67) *(LAS u32x4*)(xt + r * 72 + 8 * c8) = v[i]; } }
    asm volatile("s_waitcnt lgkmcnt(0)" ::: "memory"); __builtin_amdgcn_wave_barrier();
    { const int ch = 64 * h + lane;
      const float cw0 = c.in[11][ch], cw1 = c.in[11][1024 + ch], cw2 = c.in[11][2048 + ch], cw3 = c.in[11][3072 + ch], cbi = c.in[12][ch];
      float x0 = bf2f(xt[(3 + len - 1) * 72 + lane]), x1 = bf2f(xt[(3 + len - 2) * 72 + lane]), x2 = bf2f(xt[(3 + len - 3) * 72 + lane]);
      if (mode == 1 && (smp || cc == 127)) { float* o = smp ? c.out + O_RCS + (size_t)sb * 3072 + ch : c.out + O_RCP + (size_t)cb * 3072 + ch; o[0] = x2; o[1024] = x1; o[2048] = x0; }
      for (int tb = len - 1; tb >= 0; tb -= 8) { unsigned short rv[8];
#pragma unroll
          for (int i = 0; i < 8; ++i) rv[i] = xt[(tb - i) * 72 + lane];
#pragma unroll
          for (int i = 0; i < 8; ++i) { const float x3 = bf2f(rv[i]);
              xt[(3 + tb - i) * 72 + lane] = (bf16_t)f2bf(cbi + cw0 * x3 + cw1 * x2 + cw2 * x1 + cw3 * x0); x0 = x1; x1 = x2; x2 = x3; } } }
    asm volatile("s_waitcnt lgkmcnt(0)" ::: "memory"); __builtin_amdgcn_wave_barrier();
    const bf16_t* wg = (const bf16_t*)(c.ws + WS_WG) + (size_t)h * 8192;
    bf16x8 wf[8][2];
#pragma unroll
    for (int jt = 0; jt < 8; ++jt)
#pragma unroll
        for (int ks = 0; ks < 2; ++ks) wf[jt][ks] = *(const bf16x8*)(wg + (16 * jt + fr) * 64 + 32 * ks + 8 * fq);
    float sp[4], ba[4], bx[4], hc[4], At[4];
#pragma unroll
    for (int jt = 0; jt < 4; ++jt) { const int cg_ = 64 * h + 16 * jt + fr; const float lam = c.in[17][cg_];
        sp[jt] = -8.f * (lam > 15.f ? __expf(-lam) : log1pf(__expf(-lam)));
        ba[jt] = c.in[14][cg_]; bx[jt] = c.in[16][cg_];
        hc[jt] = mode == 1 ? (smp ? c.in[4][(size_t)sb * 1024 + cg_] : ((const float*)(c.ws + WS_HIN))[(size_t)cidx * 1024 + cg_]) : 0.f; At[jt] = 1.f; }
    bf16_t* ya = (bf16_t*)(c.ws + WS_P);
    const int ntt = len / 16;
    for (int tt = 0; tt < ntt; ++tt) {
        const bf16x8 xb0 = *(const LAS bf16x8*)(xt + (3 + 16 * tt + fr) * 72 + 8 * fq), xb1 = *(const LAS bf16x8*)(xt + (3 + 16 * tt + fr) * 72 + 32 + 8 * fq);
        f32x4 g[8];
#pragma unroll
        for (int jt = 0; jt < 8; ++jt) { g[jt] = (f32x4){0.f, 0.f, 0.f, 0.f}; g[jt] = __builtin_amdgcn_mfma_f32_16x16x32_bf16(xb0, wf[jt][0], g[jt], 0, 0, 0); g[jt] = __builtin_amdgcn_mfma_f32_16x16x32_bf16(xb1, wf[jt][1], g[jt], 0, 0, 0); }
#pragma unroll
        for (int jt = 0; jt < 4; ++jt) {
            float PA[4], PB[4];
#pragma unroll
            for (int j = 0; j < 4; ++j) { const float xv = bf2f(xt[(3 + 16 * tt + 4 * fq + j) * 72 + 16 * jt + fr]);
                const float r = sigm(g[jt][j] + ba[jt]), ig = sigm(g[jt + 4][j] + bx[jt]);
                const float a = __expf(sp[jt] * r); const float b = __builtin_amdgcn_sqrtf(fmaxf(1.f - a * a, 0.f)) * (ig * xv);
                if (j == 0) { PA[0] = a; PB[0] = b; } else { PA[j] = a * PA[j - 1]; PB[j] = a * PB[j - 1] + b; } }
            float TA = PA[3], TB = PB[3];
            { const float pa = __shfl_up(TA, 16), pb = __shfl_up(TB, 16); if (fq >= 1) { TB = TA * pb + TB; TA = TA * pa; } }
            { const float pa = __shfl_up(TA, 32), pb = __shfl_up(TB, 32); if (fq >= 2) { TB = TA * pb + TB; TA = TA * pa; } }
            if (mode == 1) {
                float EA = __shfl_up(TA, 16), EB = __shfl_up(TB, 16); if (fq == 0) { EA = 1.f; EB = 0.f; }
                const float hs = EA * hc[jt] + EB; float hv = 0.f;
#pragma unroll
                for (int j = 0; j < 4; ++j) { hv = PA[j] * hs + PB[j]; ya[(size_t)(row0 + 16 * tt + 4 * fq + j) * ZW + 64 * h + 16 * jt + fr] = (bf16_t)f2bf(hv); }
                hc[jt] = __shfl(hv, 48 + fr);
            } else { const float tA = __shfl(TA, 48 + fr), tB = __shfl(TB, 48 + fr); hc[jt] = tA * hc[jt] + tB; At[jt] *= tA; }
        }
    }
    if (fq == 0) {
#pragma unroll
        for (int jt = 0; jt < 4; ++jt) { const int cg_ = 64 * h + 16 * jt + fr;
            if (mode == 0) { ((float*)(c.ws + WS_AGGA))[(size_t)cidx * 1024 + cg_] = At[jt]; ((float*)(c.ws + WS_AGGB))[(size_t)cidx * 1024 + cg_] = hc[jt]; }
            else if (smp) c.out[O_RHS + (size_t)sb * 1024 + cg_] = hc[jt];
            else if (cc == 127) c.out[O_RHP + (size_t)cb * 1024 + cg_] = hc[jt]; }
    }
    asm volatile("s_waitcnt lgkmcnt(0)" ::: "memory"); __builtin_amdgcn_wave_barrier();
}

struct HgItem { int row0, len, h; };
__device__ __forceinline__ HgItem hg_decode(int it) { HgItem r; if (it < 2048) { const int b = it >> 10, rem = it & 1023; r.row0 = b * SEQ + 64 * (rem >> 3); r.len = 64; r.h = rem & 7; } else { const int j = it - 2048; r.row0 = MP + 32 * (j >> 3); r.len = 32; r.h = j & 7; } return r; }
__device__ __forceinline__ bf16_t* hg_U(const Ctx& c, int it) { return it < 2048 ? (bf16_t*)((unsigned char*)c.out + DO_U) + (size_t)it * 16384 : (bf16_t*)(c.ws + WS_US) + (size_t)(it - 2048) * 16384; }
__device__ __forceinline__ bf16_t* hg_ST(const Ctx& c, int it) { return it < 2048 ? (bf16_t*)((unsigned char*)c.out + DO_ST) + (size_t)it * 16384 : (bf16_t*)(c.ws + WS_STS) + (size_t)(it - 2048) * 16384; }

__device__ __forceinline__ void hg_gates(const Ctx& c, int tid, const HgItem& I, LAS float* psum, float (&g)[16], float (&kk)[16], float& boff, float& btot) {
    const int q = tid >> 7, k = tid & 127; const bf16_t* zf = (const bf16_t*)(c.ws + WS_Z + 4 * ZB);
    const float l0 = c.in[18][I.h * 128 + k], l1 = c.in[18][1024 + I.h * 128 + k]; const float lb = sigm(l0 - l1);
    float s = 0.f;
#pragma unroll
    for (int i = 0; i < 16; ++i) { const int t = 16 * q + i; const bool ok = t < I.len; const int tr = ok ? t : 0;
        const float fr_ = bf2f(zf[(size_t)(I.row0 + tr) * ZW + I.h * 128 + k]); const float f = lb + (1.f - lb) * sigm(fr_);
        const float gv = ok ? __logf(f) : 0.f; g[i] = gv; kk[i] = ok ? 1.f - f : 0.f; s += gv; }
    psum[q * 128 + k] = s;
    __syncthreads();
    const float p0 = psum[k], p1 = psum[128 + k], p2 = psum[256 + k], p3 = psum[384 + k];
    boff = q == 0 ? 0.f : (q == 1 ? p0 : (q == 2 ? p0 + p1 : p0 + p1 + p2)); btot = (p0 + p1) + (p2 + p3);
}
__device__ __forceinline__ void hg_vt_fetch(const Ctx& c, int tid, const HgItem& I, unsigned (&w)[8]) {
    const int q = tid >> 7, v = tid & 127; const bf16_t* zi = (const bf16_t*)(c.ws + WS_Z + 5 * ZB);
#pragma unroll
    for (int i = 0; i < 8; ++i) { const int t = 16 * q + 2 * i; const bool ok = t < I.len; const int tr = ok ? t : 0;
        const unsigned lo = zi[(size_t)(I.row0 + tr) * ZW + I.h * 128 + v], hi = zi[(size_t)(I.row0 + tr + 1) * ZW + I.h * 128 + v];
        w[i] = ok ? (lo | (hi << 16)) : 0u; }
}
__device__ __forceinline__ void hg_vt_store(int tid, LAS bf16_t* VT, const unsigned (&w)[8]) {
    const int q = tid >> 7, v = tid & 127;
    *(LAS u32x4*)(VT + v * 72 + 16 * q) = (u32x4){w[0], w[1], w[2], w[3]}; *(LAS u32x4*)(VT + v * 72 + 16 * q + 8) = (u32x4){w[4], w[5], w[6], w[7]};
}
__device__ __forceinline__ void hg_pass1(const Ctx& c, int it) {
    const HgItem I = hg_decode(it);
    LAS bf16_t* KdT = (LAS bf16_t*)c.lds;
    LAS bf16_t* VT = (LAS bf16_t*)(c.lds + 18432);
    LAS float* psum = (LAS float*)(c.lds + 36864);
    float g[16], kk[16], boff, btot;
    int tid = c.tid; asm volatile("" : "+v"(tid));
    unsigned vw[8]; hg_vt_fetch(c, tid, I, vw);
    hg_gates(c, tid, I, psum, g, kk, boff, btot);
    const int q = tid >> 7, k = tid & 127;
    { float bc = boff; unsigned w[8];
#pragma unroll
      for (int i = 0; i < 8; ++i) { bc += g[2 * i]; const float a = kk[2 * i] * __expf(btot - bc); bc += g[2 * i + 1]; const float b = kk[2 * i + 1] * __expf(btot - bc); w[i] = pk2(a, b); }
      *(LAS u32x4*)(KdT + k * 72 + 16 * q) = (u32x4){w[0], w[1], w[2], w[3]}; *(LAS u32x4*)(KdT + k * 72 + 16 * q + 8) = (u32x4){w[4], w[5], w[6], w[7]}; }
    if (q == 0) ((float*)(c.ws + WS_DBUF))[(size_t)it * 128 + k] = __expf(btot);
    hg_vt_store(tid, VT, vw);
    __syncthreads();
    const int fr = tid & 15, fq = (tid >> 4) & 3, w = c.wave;
    const bf16x8 a0 = *(const LAS bf16x8*)(KdT + (16 * w + fr) * 72 + 8 * fq), a1 = *(const LAS bf16x8*)(KdT + (16 * w + fr) * 72 + 32 + 8 * fq);
    bf16_t* U = hg_U(c, it);
#pragma unroll
    for (int vt = 0; vt < 8; ++vt) {
        const bf16x8 b0 = *(const LAS bf16x8*)(VT + (16 * vt + fr) * 72 + 8 * fq), b1 = *(const LAS bf16x8*)(VT + (16 * vt + fr) * 72 + 32 + 8 * fq);
        f32x4 acc = (f32x4){0.f, 0.f, 0.f, 0.f};
        acc = __builtin_amdgcn_mfma_f32_16x16x32_bf16(a0, b0, acc, 0, 0, 0); acc = __builtin_amdgcn_mfma_f32_16x16x32_bf16(a1, b1, acc, 0, 0, 0);
        u32x2 o; o.x = pk2(acc[0], acc[1]); o.y = pk2(acc[2], acc[3]);
        *(u32x2*)(U + (size_t)(16 * vt + fr) * 128 + 16 * w + 4 * fq) = o;
    }
    __syncthreads();
}
__device__ __forceinline__ void hg_scan(const Ctx& c) {
    const float* dbuf = (const float*)(c.ws + WS_DBUF);
    LAS float* dl = (LAS float*)c.lds;
    for (int p0 = c.bid * 512; p0 < 16 * 8192; p0 += c.G * 512) {
        const int seq = p0 >> 13, b = seq >> 3, h = seq & 7;
        __syncthreads();
        { f32x4 t[8];
#pragma unroll
          for (int i = 0; i < 8; ++i) { const int q = c.tid + 512 * i, ch = q >> 5, k4 = q & 31; t[i] = *(const f32x4*)(dbuf + ((size_t)b * 1024 + ch * 8 + h) * 128 + 4 * k4); }
#pragma unroll
          for (int i = 0; i < 8; ++i) ((LAS f32x4*)dl)[c.tid + 512 * i] = t[i]; }
        __syncthreads();
        const int p = p0 + c.tid, pe = p & 8191, v = pe >> 6, k2 = (pe & 63) * 2;
        float s0 = 0.f, s1 = 0.f;
        const unsigned* __restrict__ Up = (const unsigned*)((unsigned char*)c.out + DO_U); unsigned* __restrict__ Sp = (unsigned*)((unsigned char*)c.out + DO_ST);
        const size_t e0 = ((size_t)b * 1024 + h) * 8192 + (size_t)v * 64 + (k2 >> 1);
        for (int cb0 = 0; cb0 < 128; cb0 += 32) {
            unsigned u[32];
#pragma unroll
            for (int i = 0; i < 32; ++i) u[i] = Up[e0 + (size_t)(cb0 + i) * 65536];
#pragma unroll
            for (int i = 0; i < 32; ++i) { const f32x2 d = *(const LAS f32x2*)(dl + (cb0 + i) * 128 + k2);
                Sp[e0 + (size_t)(cb0 + i) * 65536] = cvt_pk_bf16(s0, s1); s0 = d[0] * s0 + bflo(u[i]); s1 = d[1] * s1 + bfhi(u[i]); }
        }
        float* o = c.out + O_HGP + (size_t)seq * 16384; o[(size_t)k2 * 128 + v] = s0; o[(size_t)(k2 + 1) * 128 + v] = s1;
    }
    __syncthreads();
    for (int p = c.bid * 512 + c.tid; p < 128 * 16384; p += c.G * 512) {
        const int seq = p >> 14, e = p & 16383, k = e >> 7, v = e & 127; const int it = 2048 + seq;
        const float s = c.in[6][p]; const float d = dbuf[(size_t)it * 128 + k]; const float u = bf2f(((const bf16_t*)(c.ws + WS_US))[(size_t)seq * 16384 + v * 128 + k]);
        c.out[O_HGS + p] = d * s + u;
    }
}
__device__ __forceinline__ void hg_pass3(const Ctx& c, int it) {
    const HgItem I = hg_decode(it);
    LAS bf16_t* Q0 = (LAS bf16_t*)c.lds;
    LAS bf16_t* QE = (LAS bf16_t*)(c.lds + 17408);
    LAS bf16_t* KE = (LAS bf16_t*)(c.lds + 34816);
    LAS bf16_t* VT = (LAS bf16_t*)(c.lds + 52224);
    LAS bf16_t* AM = (LAS bf16_t*)(c.lds + 70656);
    LAS bf16_t* STl = (LAS bf16_t*)(c.lds + 79872);
    LAS float* psum = (LAS float*)(c.lds + 114688);
    LAS float* red = (LAS float*)(c.lds + 116736);
    float g[16], kk[16], boff, btot;
    int tid = c.tid; asm volatile("" : "+v"(tid));
    unsigned vw[8]; hg_vt_fetch(c, tid, I, vw);
    u32x4 stv[4]; { const u32x4* src = (const u32x4*)hg_ST(c, it);
#pragma unroll
      for (int i = 0; i < 4; ++i) stv[i] = src[tid + 512 * i]; }
    unsigned short qraw[16]; { const bf16_t* zq = (const bf16_t*)(c.ws + WS_Z + 3 * ZB); const int q_ = tid >> 7, k_ = tid & 127;
#pragma unroll
      for (int i = 0; i < 16; ++i) { const int t = 16 * q_ + i; const int tr = t < I.len ? t : 0; qraw[i] = zq[(size_t)(I.row0 + tr) * ZW + I.h * 128 + k_]; } }
    hg_gates(c, tid, I, psum, g, kk, boff, btot);
    const int q = tid >> 7, k = tid & 127;
    {
      const float p0 = psum[k], p1 = psum[128 + k]; const float ref = I.len == 64 ? p0 + p1 : p0;
      float bc = boff;
#pragma unroll
      for (int i = 0; i < 16; ++i) { const int t = 16 * q + i; bc += g[i]; const bool ok = t < I.len;
          float qv = bf2f(qraw[i]); qv = ok ? qv : 0.f;
          Q0[t * 136 + k] = (bf16_t)f2bf(qv * __expf(bc)); QE[t * 136 + k] = (bf16_t)f2bf(qv * __expf(bc - ref)); KE[t * 136 + k] = (bf16_t)f2bf(kk[i] * __expf(ref - bc)); } }
    hg_vt_store(tid, VT, vw);
    {
#pragma unroll
      for (int i = 0; i < 4; ++i) { const int ci = tid + 512 * i; const int v = ci >> 4, kc = ci & 15; *(LAS u32x4*)(STl + v * 136 + 8 * kc) = stv[i]; } }
    __syncthreads();
    const int fr = tid & 15, fq = (tid >> 4) & 3, w = c.wave;
    { const int tt = w >> 1;
#pragma unroll
      for (int si = 0; si < 2; ++si) { const int st = 2 * (w & 1) + si; f32x4 acc = (f32x4){0.f, 0.f, 0.f, 0.f};
          if (st <= tt) {
#pragma unroll
              for (int ks = 0; ks < 4; ++ks) { const bf16x8 a = *(const LAS bf16x8*)(QE + (16 * tt + fr) * 136 + 32 * ks + 8 * fq), b = *(const LAS bf16x8*)(KE + (16 * st + fr) * 136 + 32 * ks + 8 * fq);
                  acc = __builtin_amdgcn_mfma_f32_16x16x32_bf16(a, b, acc, 0, 0, 0); } }
#pragma unroll
          for (int j = 0; j < 4; ++j) { const int t = 16 * tt + 4 * fq + j, s = 16 * st + fr; AM[t * 72 + s] = (bf16_t)f2bf(s <= t ? acc[j] : 0.f); } } }
    __syncthreads();
    const int tt = w & 3, vh = w >> 2;
    bf16x8 bq[4], ba_[2];
#pragma unroll
    for (int ks = 0; ks < 4; ++ks) bq[ks] = *(const LAS bf16x8*)(Q0 + (16 * tt + fr) * 136 + 32 * ks + 8 * fq);
#pragma unroll
    for (int ks = 0; ks < 2; ++ks) ba_[ks] = *(const LAS bf16x8*)(AM + (16 * tt + fr) * 72 + 32 * ks + 8 * fq);
    f32x4 o[4]; float ss = 0.f;
#pragma unroll
    for (int vi = 0; vi < 4; ++vi) { const int vt = 4 * vh + vi; o[vi] = (f32x4){0.f, 0.f, 0.f, 0.f};
#pragma unroll
        for (int ks = 0; ks < 4; ++ks) { const bf16x8 a = *(const LAS bf16x8*)(STl + (16 * vt + fr) * 136 + 32 * ks + 8 * fq); o[vi] = __builtin_amdgcn_mfma_f32_16x16x32_bf16(a, bq[ks], o[vi], 0, 0, 0); }
#pragma unroll
        for (int ks = 0; ks < 2; ++ks) { const bf16x8 a = *(const LAS bf16x8*)(VT + (16 * vt + fr) * 72 + 32 * ks + 8 * fq); o[vi] = __builtin_amdgcn_mfma_f32_16x16x32_bf16(a, ba_[ks], o[vi], 0, 0, 0); }
        ss += (o[vi][0] * o[vi][0] + o[vi][1] * o[vi][1]) + (o[vi][2] * o[vi][2] + o[vi][3] * o[vi][3]); }
    ss += __shfl_xor(ss, 16); ss += __shfl_xor(ss, 32);
    if (fq == 0) red[vh * 64 + 16 * tt + fr] = ss;
    __syncthreads();
    const int t = 16 * tt + fr;
    if (t < I.len) { const float rs = rsqrtf((red[t] + red[64 + t]) * (1.f / 128.f) + EPS);
        bf16_t* yb = (bf16_t*)(c.ws + WS_Z + 0 * ZB) + (size_t)(I.row0 + t) * ZW + I.h * 128;
#pragma unroll
        for (int vi = 0; vi < 4; ++vi) { const int v0 = 16 * (4 * vh + vi) + 4 * fq; const u32x2 og = *(const u32x2*)(yb + v0); const f32x4 gn = *(const f32x4*)(c.in[19] + v0);
            u32x2 wv; wv.x = pk2(o[vi][0] * rs * gn[0] * sigm(bflo(og.x)), o[vi][1] * rs * gn[1] * sigm(bfhi(og.x))); wv.y = pk2(o[vi][2] * rs * gn[2] * sigm(bflo(og.y)), o[vi][3] * rs * gn[3] * sigm(bfhi(og.y)));
            *(u32x2*)(yb + v0) = wv; } }
    __syncthreads();
}

__device__ __forceinline__ float load_pre_row(const Ctx& c, int m, const bf16_t* Y, const float* slab, int nsl, f32x4 (&y)[8]) {
    float s = 0.f;
    if (m < MP) { const u32x2* yp = (const u32x2*)(Y + (size_t)m * D) + c.lane;
#pragma unroll
        for (int j = 0; j < 8; ++j) { const u32x2 w = yp[64 * j]; y[j] = (f32x4){bflo(w.x), bfhi(w.x), bflo(w.y), bfhi(w.y)}; } }
    else {
#pragma unroll
        for (int j = 0; j < 8; ++j) y[j] = (f32x4){0.f, 0.f, 0.f, 0.f};
        for (int sl = 0; sl < nsl; ++sl) { const f32x4* sp = (const f32x4*)(slab + ((size_t)sl * 512 + (m - MP)) * D) + c.lane;
#pragma unroll
            for (int j = 0; j < 8; ++j) y[j] += sp[64 * j]; } }
#pragma unroll
    for (int j = 0; j < 8; ++j) s += (y[j][0] * y[j][0] + y[j][1] * y[j][1]) + (y[j][2] * y[j][2] + y[j][3] * y[j][3]);
    return wave_sum(s);
}
__device__ __forceinline__ void phase_norm_mid(const Ctx& c) {
    const int gw = c.bid * 8 + c.wave, NGW = c.G * 8;
    for (int m = gw; m < M; m += NGW) {
        f32x4 y[8]; const float rs = rsqrtf(load_pre_row(c, m, (const bf16_t*)(c.ws + WS_YPRE), (const float*)(c.ws + WS_SLAB6), 8, y) * (1.f / D) + EPS);
        const f32x4* xr = (const f32x4*)xrow_ptr(c, m) + c.lane; float s2 = 0.f;
        u32x2* xf = (u32x2*)((bf16_t*)(c.ws + WS_XF) + (size_t)m * D) + c.lane;
#pragma unroll
        for (int j = 0; j < 8; ++j) { const f32x4 x = __builtin_nontemporal_load(&xr[64 * j]); const f32x4 g = ((const f32x4*)c.in[25])[c.lane + 64 * j];
            y[j] = x + y[j] * rs * g; s2 += (y[j][0] * y[j][0] + y[j][1] * y[j][1]) + (y[j][2] * y[j][2] + y[j][3] * y[j][3]);
            u32x2 w; w.x = cvt_pk_bf16(y[j][0], y[j][1]); w.y = cvt_pk_bf16(y[j][2], y[j][3]); xf[64 * j] = w; }
        const float r2 = rsqrtf(wave_sum(s2) * (1.f / D) + EPS);
        if (c.lane == 0) ((float*)(c.ws + WS_R2))[m] = r2;
    }
}
__device__ __forceinline__ void phase_norm_fin(const Ctx& c) {
    const int gw = c.bid * 8 + c.wave, NGW = c.G * 8;
    for (int m = gw; m < M; m += NGW) {
        f32x4 y[8]; const float rs = rsqrtf(load_pre_row(c, m, (const bf16_t*)(c.ws + WS_YPRE2), (const float*)(c.ws + WS_SLAB9), 11, y) * (1.f / D) + EPS);
        f32x4* o = (f32x4*)(c.out + (size_t)m * D) + c.lane; const u32x2* x1 = (const u32x2*)((const bf16_t*)(c.ws + WS_XF) + (size_t)m * D) + c.lane;
#pragma unroll
        for (int j = 0; j < 8; ++j) { const f32x4 g = ((const f32x4*)c.in[31])[c.lane + 64 * j]; const u32x2 w = x1[64 * j];
            __builtin_nontemporal_store((f32x4){bflo(w.x), bfhi(w.x), bflo(w.y), bfhi(w.y)} + y[j] * rs * g, &o[64 * j]); }
    }
}

#define XB_TMO      128
#define XB_XCNT(j)  (256  + 64 * (j))
#define XB_XSUB(j)  (1280 + 64 * (j))
#define XB_XGEN(j)  (2304 + 64 * (j))
#define XB_TOP      3328
#define XB_TOPGEN   3392
#define XCD_BAR_WORDS 3456
#define XB_SPIN_CAP (1u << 20)
__device__ __forceinline__ unsigned xb_ld(unsigned* p)              { return __hip_atomic_load(p, __ATOMIC_RELAXED, __HIP_MEMORY_SCOPE_AGENT); }
__device__ __forceinline__ unsigned xb_add(unsigned* p, unsigned v) { return __hip_atomic_fetch_add(p, v, __ATOMIC_RELAXED, __HIP_MEMORY_SCOPE_AGENT); }
__device__ __forceinline__ unsigned xb_xcc_id() { return (unsigned)__builtin_amdgcn_s_getreg((3 << 11) | 20) & 0xFu; }
#define XB_SPIN(cond, bar) do { unsigned _sp = 0; while (cond) { __builtin_amdgcn_s_sleep(1); \
    if ((++_sp & 255u) == 0u) { if (xb_ld(&(bar)[XB_TMO])) break; if (_sp > XB_SPIN_CAP) { atomicAdd(&(bar)[XB_TMO], 1u); break; } } } } while (0)
struct XcdBarrier { unsigned* bar; unsigned x; volatile LAS unsigned* st; };
__device__ __forceinline__ XcdBarrier xcd_barrier_post(unsigned* bar, volatile LAS unsigned* st) {
    XcdBarrier b; b.bar = bar; b.x = xb_xcc_id(); b.st = st;
    if (threadIdx.x == 0) (void)xb_add(&bar[XB_XCNT(b.x)], 1u);
    return b;
}
__device__ __forceinline__ void xcd_barrier_complete(unsigned* bar, unsigned x, unsigned& nloc, unsigned& nx) {
    const unsigned G = gridDim.x * gridDim.y * gridDim.z;
    unsigned sum, cnt, mine, sp = 0u;
    for (;;) {
        sum = 0u; cnt = 0u; mine = 0u;
#pragma unroll
        for (unsigned j = 0; j < 16; ++j) { const unsigned c = xb_ld(&bar[XB_XCNT(j)]); sum += c; cnt += (c > 0u) ? 1u : 0u; mine = (j == x) ? c : mine; }
        if (sum == G) break;
        __builtin_amdgcn_s_sleep(1);
        if ((++sp & 255u) == 0u) { if (xb_ld(&bar[XB_TMO])) break; if (sp > XB_SPIN_CAP) { atomicAdd(&bar[XB_TMO], 1u); break; } }
    }
    nloc = mine > 0u ? mine : 1u; nx = cnt > 0u ? cnt : 1u;
}
__device__ __forceinline__ void xcd_barrier(const XcdBarrier& b) {
    asm volatile("s_waitcnt vmcnt(0)" ::: "memory");
    __syncthreads();
    if (threadIdx.x == 0) {
        unsigned* bar = b.bar;
        __builtin_amdgcn_s_waitcnt(0);
        unsigned nloc = b.st[0], nx = b.st[1];
        if (nloc == 0u) { xcd_barrier_complete(bar, b.x, nloc, nx); b.st[0] = nloc; b.st[1] = nx; }
        const unsigned old = xb_add(&bar[XB_XSUB(b.x)], 1u);
        const unsigned gen = old / nloc;
        if (old + 1u == (gen + 1u) * nloc) {
            __builtin_amdgcn_fence(__ATOMIC_RELEASE, "agent");
            asm volatile("s_waitcnt vmcnt(0)" ::: "memory");
            const unsigned og = xb_add(&bar[XB_TOP], 1u);
            const unsigned tg = og / nx;
            if (og + 1u == (tg + 1u) * nx) xb_add(&bar[XB_TOPGEN], 1u);
            else XB_SPIN(xb_ld(&bar[XB_TOPGEN]) == tg, bar);
            __builtin_amdgcn_fence(__ATOMIC_ACQUIRE, "agent");
            xb_add(&bar[XB_XGEN(b.x)], 1u);
            asm volatile("s_waitcnt vmcnt(0)" ::: "memory");
        } else {
            XB_SPIN(xb_ld(&bar[XB_XGEN(b.x)]) == gen, bar);
            __builtin_amdgcn_fence(__ATOMIC_ACQUIRE, "agent");
            asm volatile("s_waitcnt vmcnt(0)" ::: "memory");
        }
    }
    __syncthreads();
}

struct Args { const float* in[32]; float* out; unsigned char* ws; int ph_lo, ph_hi, rep, pad; };

__global__ void __launch_bounds__(512, 2) fwd_kernel(Args args) {
    extern __shared__ __attribute__((aligned(16))) unsigned char lds_raw[];
    Ctx c; c.lds = (LAS unsigned char*)lds_raw; c.tid = threadIdx.x; c.lane = c.tid & 63; c.wave = __builtin_amdgcn_readfirstlane(c.tid >> 6); c.G = gridDim.x; c.bid = blockIdx.x;
    c.in = args.in; c.out = args.out; c.ws = args.ws;
    const int lo = args.ph_lo, hi = args.ph_hi;
#define REP(bit) for (int r_ = 0, n_ = 1 + ((args.rep >> (bit)) & 1); r_ < n_; ++r_)
    const int gw = c.bid * 8 + c.wave, NGW = c.G * 8;
    bf16_t* Z = (bf16_t*)(c.ws + WS_Z);
#ifndef PHMASK
#define PHMASK 0x7ff
#endif
#define IN(k) (((PHMASK >> (k)) & 1) && lo <= (k) && (k) < hi)
#define SEAM(k) do { if (IN(k) && IN((k) + 1)) { xcd_barrier(bar); } } while (0)
    volatile LAS unsigned* misc = (volatile LAS unsigned*)(c.lds + 131072);
    if (c.tid < 8) misc[c.tid] = 0u;
    __syncthreads();
    XcdBarrier bar = xcd_barrier_post((unsigned*)c.ws, misc);
    if (lo < 0) cg::this_grid().sync();

    if (IN(0)) { REP(0) phase_prep(c); }
    SEAM(0);
    if (IN(1)) {
        { OpPlain op{(const bf16_t*)((unsigned char*)c.out + DO_XN), (const bf16_t*)((unsigned char*)c.out + DO_WIN), 2048, 2048, 2048}; Order S; S.init(M / 256, 48, c.G, c.bid, 1, WGM_P1);
          EpiZ E{Z}; pg8::gemm_phase<EpiZ, OpPlain>(c.lds, op, S, E); }
        __syncthreads();
        if (c.G == 256 && c.bid >= 96 && c.bid < c.G - 16) prep_late(c, (c.bid - 96) * 8 + c.wave, 144 * 8);
        else if (c.G != 256) prep_late(c, c.bid * 8 + c.wave, c.G * 8);
        if (c.bid >= c.G - 16) {
          OpPlain op{(const bf16_t*)(c.ws + WS_MEMN), (const bf16_t*)(c.ws + WS_WKV), 2048, 2048, 2048}; Order S; S.init(2, 8, 16, c.bid - (c.G - 16));
          EpiKV E{c.out, (bf16_t*)(c.ws + WS_KBP)}; pg8::gemm_phase<EpiKV, OpPlain>(c.lds, op, S, E); }
    }
    SEAM(1);
    if (IN(2)) {
#if !defined(P2SEL) || P2SEL==0
        { OpAttn op{Z + 1 * (size_t)M * ZW, (const bf16_t*)(c.ws + WS_KBP), (const bf16_t*)(c.ws + WS_KBS), 256, 1024, 1024, 0}; Order S; S.init(320, 1, c.G, c.bid);
          EpiS E{(bf16_t*)(c.ws + WS_P), (float*)(c.ws + WS_RS)}; pg8::gemm_phase<EpiS, OpAttn>(c.lds, op, S, E); }
#endif
        __syncthreads();
        { LAS float* scr = (LAS float*)(c.lds + c.wave * 16384);
          for (int r = gw - 64 * 8; r >= 0 && r < 2 * 128; r += NGW) { const int b = r >> 7; transpose_job(c.out + O_MV + (size_t)b * 262144, 256, 1024, (bf16_t*)(c.ws + WS_VTP) + (size_t)b * 262144, 256, r & 127, scr, c.lane, [](int n0) { return n0; }); } }
        __syncthreads();
#if !defined(P2SEL) || P2SEL==1
        REP(1) for (int it = c.G - 1 - c.bid; it < 2176; it += c.G) hg_pass1(c, it);
#endif
        __syncthreads();
#if !defined(P2SEL) || P2SEL==2
        REP(2) for (int r = gw; r < 256 * 16; r += NGW) lru_item(c, r >> 4, r & 15, 0, c.lds + c.wave * 9728);
#endif
    }
    SEAM(2);
    if (IN(3)) {
        { OpAttn op{(const bf16_t*)(c.ws + WS_P), (const bf16_t*)(c.ws + WS_VTP), (const bf16_t*)(c.ws + WS_VTS), 256, 1024, 256, 1}; Order S; S.init(320, 1, c.G, c.bid);
          EpiPV E{Z + 1 * (size_t)M * ZW, (const float*)(c.ws + WS_RS)}; pg8::gemm_phase<EpiPV, OpAttn>(c.lds, op, S, E); }
        __syncthreads();
        for (int p = (c.G - 1 - c.bid) * 512 + c.tid; p < 2048; p += c.G * 512) { const int b = p >> 10, ch = p & 1023; float h = 0.f;
            const float* A = (const float*)(c.ws + WS_AGGA); const float* B = (const float*)(c.ws + WS_AGGB); float* H = (float*)(c.ws + WS_HIN);
            for (int k0 = 0; k0 < 128; k0 += 16) { float av[16], bv[16];
#pragma unroll
                for (int i = 0; i < 16; ++i) { const size_t e = (size_t)(b * 128 + k0 + i) * 1024 + ch; av[i] = A[e]; bv[i] = B[e]; }
#pragma unroll
                for (int i = 0; i < 16; ++i) { const size_t e = (size_t)(b * 128 + k0 + i) * 1024 + ch; H[e] = h; h = av[i] * h + bv[i]; } } }
        REP(3) hg_scan(c);
    }
    SEAM(3);
    if (IN(4)) {
        for (int it = c.bid; it < 2176; it += c.G) hg_pass3(c, it);
        __syncthreads();
        for (int r = NGW - 1 - gw; r < 272 * 16; r += NGW) lru_item(c, r >> 4, r & 15, 1, c.lds + c.wave * 9728);
    }
    SEAM(4);
    if (IN(5)) {
        const bool conv_first = (c.bid & 1) != 0; const bool full = c.G == 256;
        for (int pass = 0; pass < 2; ++pass) {
            if ((pass == 0) == conv_first) {
                if (!full || c.bid >= 48) {
                  LAS float* scr = (LAS float*)(c.lds + c.wave * 16384); constexpr int I_UP = 32 * 352, I_DN = 88 * 64;
                  const int w0 = full ? (c.bid - 48) * 8 + c.wave : c.bid * 8 + c.wave, nw = full ? (c.G - 48) * 8 : c.G * 8;
                  for (int it = w0; it < (full ? I_UP : I_UP + I_DN); it += nw) {
                      if (it < I_UP) transpose_job(c.in[27], 2048, 11264, (bf16_t*)(c.ws + WS_WUP), 2048, it, scr, c.lane, [](int n0) { const int isv = n0 >= FF, n = isv ? n0 - FF : n0; return (n >> 7) * 256 + isv * 128 + (n & 127); }, c.in[26]);
                      else transpose_job(c.in[30], FF, 2048, (bf16_t*)(c.ws + WS_WDN), FF, it - I_UP, scr, c.lane, [](int n0) { return n0; }); } }
            } else {
                OpMerge op{(const bf16_t*)(c.ws + WS_P), Z + 0 * (size_t)M * ZW, Z + 1 * (size_t)M * ZW, (const bf16_t*)(c.ws + WS_WBR), 1024, 1024, 1024}; pg8::MergeOrder S; S.init(M / 256, 8, c.G, c.bid, pg8::WGM);
                EpiMerge E{Z + 6 * (size_t)M * ZW, c.in[23], (bf16_t*)(c.ws + WS_MM), (unsigned*)c.ws + 4096}; pg8::gemm_phase<EpiMerge, OpMerge, pg8::MergeOrder>(c.lds, op, S, E);
            }
            __syncthreads();
        }
    }
    SEAM(5);
    if (IN(6)) {
        { OpPlain op{(const bf16_t*)(c.ws + WS_MM), (const bf16_t*)(c.ws + WS_WOUT), 2048, 2048, 2048}; Order S; S.init(MP / 256, 8, c.G, c.bid);
          EpiPre E{(bf16_t*)(c.ws + WS_YPRE)}; pg8::gemm_phase<EpiPre, OpPlain>(c.lds, op, S, E); }
        __syncthreads();
        { OpSplit op{(const bf16_t*)(c.ws + WS_MM), (const bf16_t*)(c.ws + WS_WOUT), 256, 2048, 2048}; Order S; S.init(2 * 8, 8, c.G, c.bid);
          EpiSlab E{(float*)(c.ws + WS_SLAB6)}; pg8::gemm_phase<EpiSlab, OpSplit>(c.lds, op, S, E); }
    }
    SEAM(6);
    if (IN(7)) { REP(7) phase_norm_mid(c); }
    SEAM(7);
    if (IN(8)) {
        OpUp op{(const bf16_t*)(c.ws + WS_XF), (const bf16_t*)(c.ws + WS_WUP), 2048, 2048, 2048}; Order S; S.init(68, 44, c.G, c.bid, 1, WGM_P8);
        EpiUp E{(bf16_t*)(c.ws + WS_ACT), c.in[28], c.in[29], c.in[7], c.out, (const float*)(c.ws + WS_R2)}; pg8::gemm_phase<EpiUp, OpUp>(c.lds, op, S, E);
        __syncthreads();
        if (c.G == 256 && c.bid >= 176) {
          LAS float* scr = (LAS float*)(c.lds + c.wave * 16384); constexpr int I_DN = 88 * 64;
          for (int it = (c.bid - 176) * 8 + c.wave; it < I_DN; it += 80 * 8) transpose_job(c.in[30], FF, 2048, (bf16_t*)(c.ws + WS_WDN), FF, it, scr, c.lane, [](int n0) { return n0; }); }
    }
    SEAM(8);
    if (IN(9)) {
        { OpPlain op{(const bf16_t*)(c.ws + WS_ACT), (const bf16_t*)(c.ws + WS_WDN), FF, FF, FF}; Order S; S.init(MP / 256, 8, c.G, c.bid);
          EpiPre E{(bf16_t*)(c.ws + WS_YPRE2)}; pg8::gemm_phase<EpiPre, OpPlain>(c.lds, op, S, E); }
        __syncthreads();
        { OpSplit op{(const bf16_t*)(c.ws + WS_ACT), (const bf16_t*)(c.ws + WS_WDN), 512, FF, FF}; Order S; S.init(2 * 11, 8, c.G, c.bid);
          EpiSlab E{(float*)(c.ws + WS_SLAB9)}; pg8::gemm_phase<EpiSlab, OpSplit>(c.lds, op, S, E); }
    }
    SEAM(9);
    if (IN(10)) { phase_norm_fin(c); }
#undef IN
#undef SEAM
}

extern "C" void kernel_launch(void* const* d_in, const int* in_sizes, int n_in, void* d_out, int out_size, void* d_ws, size_t ws_size, hipStream_t stream) {
    static int grid = 0;
    if (grid == 0) {
        if (n_in != 32 || (size_t)out_size != O_END || ws_size < WS_END) { fprintf(stderr, "kernel_launch: unexpected shapes (n_in %d out %d ws %zu)\n", n_in, out_size, ws_size); grid = -1; return; }
        int dev = 0, cus = 0, per_cu = 0;
        hipGetDevice(&dev); hipDeviceGetAttribute(&cus, hipDeviceAttributeMultiprocessorCount, dev);
        hipFuncSetAttribute((const void*)fwd_kernel, hipFuncAttributeMaxDynamicSharedMemorySize, LDS_BYTES);
        hipOccupancyMaxActiveBlocksPerMultiprocessor(&per_cu, (const void*)fwd_kernel, 512, LDS_BYTES);
        if (per_cu < 1) per_cu = 1;
        grid = cus * 1;
        (void)hipGetLastError();
    }
    if (grid < 0) return;
    if (hipMemsetAsync(d_ws, 0, 32768, stream) != hipSuccess) { fprintf(stderr, "memset failed\n"); return; }
    Args a{};
    for (int i = 0; i < 32; ++i) a.in[i] = (const float*)d_in[i];
    a.out = (float*)d_out; a.ws = (unsigned char*)d_ws;
#if MK_LAUNCHES == 1
    a.ph_lo = 0; a.ph_hi = NPH;
    void* kargs[] = {&a};
    hipError_t e = hipLaunchCooperativeKernel((const void*)fwd_kernel, dim3(grid), dim3(512), kargs, LDS_BYTES, stream);
    if (e != hipSuccess) fprintf(stderr, "cooperative launch failed: %s (grid %d)\n", hipGetErrorString(e), grid);
#else
#ifdef REPMASK
    a.rep = REPMASK;
#endif
    for (int p = 0; p < NPH; ++p) { a.ph_lo = p; a.ph_hi = p + 1; hipLaunchKernelGGL(fwd_kernel, dim3(grid), dim3(512), LDS_BYTES, stream, a);
#ifdef DUPMASK
        if ((DUPMASK >> p) & 1) hipLaunchKernelGGL(fwd_kernel, dim3(grid), dim3(512), LDS_BYTES, stream, a);
#endif
    }
#endif
}
```

```cpp
#include <hip/hip_runtime.h>
#include <hip/hip_cooperative_groups.h>
#include <cstdio>
#include <cstdint>
namespace cg = cooperative_groups;

#ifndef MK_LAUNCHES
#define MK_LAUNCHES 1
#endif

#define LAS __attribute__((address_space(3)))
typedef unsigned short bf16_t;
typedef short bf16x8 __attribute__((ext_vector_type(8)));
typedef float f32x4 __attribute__((ext_vector_type(4)));
typedef float f32x2 __attribute__((ext_vector_type(2)));
typedef unsigned u32x4 __attribute__((ext_vector_type(4)));
typedef unsigned u32x2 __attribute__((ext_vector_type(2)));

constexpr int D = 2048, SEQ = 8192, MP = 16384, MS = 512, M = MP + MS, ZW = 1024, FF = 5632;
constexpr float EPS = 1e-6f;
constexpr size_t MiB = (size_t)1 << 20;
constexpr size_t ZB = (size_t)M * ZW * 2;
constexpr size_t WS_AGGA = 1 * MiB, WS_AGGB = 2 * MiB, WS_HIN = 3 * MiB, WS_DBUF = 4 * MiB, WS_RS = 6 * MiB, WS_SSQ = 8 * MiB, WS_WG = 11 * MiB, WS_US = 12 * MiB;
constexpr size_t WS_Z = 16 * MiB;
constexpr size_t WS_WBR = WS_Z + 12 * ZB;
constexpr size_t WS_WOUT = WS_WBR + 12 * MiB;
constexpr size_t WS_P = WS_WOUT + 8 * MiB;
constexpr size_t WS_KBP = WS_P + ZB;
constexpr size_t WS_VTP = WS_KBP + 1 * MiB;
constexpr size_t WS_KBS = WS_VTP + 1 * MiB;
constexpr size_t WS_VTS = WS_KBS + 8 * MiB;
constexpr size_t WS_WKV = WS_VTS + 8 * MiB;
constexpr size_t WS_MEMN = WS_WKV + 8 * MiB;
constexpr size_t WS_STS = WS_MEMN + 2 * MiB;
constexpr size_t WS_END = WS_STS + 4 * MiB;
constexpr size_t WS_MM = WS_Z + 2 * ZB;
constexpr size_t WS_WUP = WS_Z + 4 * ZB;
constexpr size_t WS_WDN = WS_WUP + 44 * MiB;
constexpr size_t WS_YPRE = WS_Z + 0 * ZB;
constexpr size_t WS_XF = WS_YPRE;
constexpr size_t WS_ACT = WS_Z + 6 * ZB;
constexpr size_t WS_SLAB6 = WS_P;
constexpr size_t WS_SLAB9 = WS_WUP;
constexpr size_t WS_YPRE2 = WS_Z + 2 * ZB;
constexpr size_t WS_R2 = 8 * MiB;
constexpr size_t DO_XN = 0, DO_WIN = 66 * MiB, DO_U = 0, DO_ST = 64 * MiB;
constexpr size_t O_Y = 0, O_MK = (size_t)M * D, O_MV = O_MK + 524288, O_RHP = O_MV + 524288, O_RCP = O_RHP + 2048, O_HGP = O_RCP + 6144, O_FCP = O_HGP + 262144,
                 O_RHS = O_FCP + 22528, O_RCS = O_RHS + 16384, O_HGS = O_RCS + 49152, O_FCS = O_HGS + 2097152, O_END = O_FCS + 180224;

constexpr int LDS_BYTES = 131072 + 1024;
constexpr int NPH = 11;
#define WGM_P1 4
#define WGM_P8 4

__device__ __forceinline__ unsigned f2bf(float f) { unsigned u = __builtin_bit_cast(unsigned, f); return (u + 0x7fffu + ((u >> 16) & 1u)) >> 16; }
__device__ __forceinline__ unsigned pk2(float lo, float hi) { return f2bf(lo) | (f2bf(hi) << 16); }
__device__ __forceinline__ float bf2f(unsigned b) { return __builtin_bit_cast(float, b << 16); }
__device__ __forceinline__ float bflo(unsigned w) { return __builtin_bit_cast(float, w << 16); }
__device__ __forceinline__ float bfhi(unsigned w) { return __builtin_bit_cast(float, w & 0xffff0000u); }
__device__ __forceinline__ float sigm(float x) { return __builtin_amdgcn_rcpf(1.f + __expf(-x)); }
__device__ __forceinline__ float wave_sum(float v) {
#pragma unroll
    for (int o = 1; o < 64; o <<= 1) v += __shfl_xor(v, o);
    return v;
}
__device__ __forceinline__ unsigned cvt_pk_bf16(float lo, float hi) { unsigned r; asm volatile("v_cvt_pk_bf16_f32 %0, %1, %2" : "=v"(r) : "v"(lo), "v"(hi)); return r; }
__device__ __forceinline__ u32x4 pack8(f32x4 a, f32x4 b) { u32x4 w; w.x = cvt_pk_bf16(a[0], a[1]); w.y = cvt_pk_bf16(a[2], a[3]); w.z = cvt_pk_bf16(b[0], b[1]); w.w = cvt_pk_bf16(b[2], b[3]); return w; }
__device__ __forceinline__ void unpack8(u32x4 w, f32x4& a, f32x4& b) { a = (f32x4){bflo(w.x), bfhi(w.x), bflo(w.y), bfhi(w.y)}; b = (f32x4){bflo(w.z), bfhi(w.z), bflo(w.w), bfhi(w.w)}; }

namespace pg8 {
constexpr int BM = 256, BK = 64, HALF = 128, HTB = HALF * BK * 2, STAGE_BYTES = 8 * HTB, NXCD = 8, WGM = 8;
__host__ __device__ __forceinline__ int lds_byte(int r, int c) { const int st = (r >> 4) * 2 + (c >> 5), rr = r & 15, cc = c & 31, ob = rr * 64 + cc * 2; return st * 1024 + (ob ^ (((ob >> 9) & 1) << 5)); }
__host__ __device__ __forceinline__ void stage_rc(int b, int& R, int& C) { const int st = b / 1024, sb = b % 1024, swz = sb ^ (((sb >> 9) & 1) << 5); R = (st >> 1) * 16 + swz / 64; C = (st & 1) * 32 + (swz % 64) / 2; }
__host__ __device__ __forceinline__ int perm32(int rho) { const int n = rho >> 4, i = rho & 15; return 8 * (i >> 2) + 4 * n + (i & 3); }

struct Unit { int pm, pn, aux; };
struct Order {
    int nM, nN, nwg, G, c, rep, wgm;
    __device__ void init(int nM_, int nN_, int G_, int c_, int rep_ = 1, int wgm_ = WGM) { nM = nM_; nN = nN_; nwg = nM * nN; G = G_; c = c_; rep = rep_; wgm = wgm_; }
    __device__ bool next(int i, Unit& u) const {
        const long L = (long)(i / rep) * G + c; if (L >= nwg) return false;
        int wgid = (int)L; { const int q = nwg / NXCD, r = nwg % NXCD, xcd = wgid % NXCD, off = wgid / NXCD; wgid = (xcd < r ? xcd * (q + 1) : r * (q + 1) + (xcd - r) * q) + off; }
        const int nig = wgm * nN, gid = wgid / nig, fm = gid * wgm, gsz = (nM - fm) < wgm ? (nM - fm) : wgm;
        u.pm = fm + ((wgid % nig) % gsz); u.pn = (wgid % nig) / gsz; u.aux = i % rep; return true;
    }
};

struct MergeOrder {
    int nM, nN, nwg, G, c, wgm;
    __device__ void init(int nM_, int nN_, int G_, int c_, int wgm_) { nM = nM_; nN = nN_; nwg = nM * nN; G = G_; c = c_; wgm = wgm_; }
    __device__ void tile(long L, Unit& u) const {
        int wgid = (int)L; { const int q = nwg / NXCD, r = nwg % NXCD, xcd = wgid % NXCD, off = wgid / NXCD; wgid = (xcd < r ? xcd * (q + 1) : r * (q + 1) + (xcd - r) * q) + off; }
        const int nig = wgm * nN, gid = wgid / nig, fm = gid * wgm, gsz = (nM - fm) < wgm ? (nM - fm) : wgm;
        u.pm = fm + ((wgid % nig) % gsz); u.pn = (wgid % nig) / gsz;
    }
    __device__ bool next(int i, Unit& u) const {
        if (G != 256 || nwg != 528) { const long L = (long)(i / 3) * G + c; if (L >= nwg) return false; tile(L, u); u.aux = i % 3; return true; }
        int k = i;
        if (c < 16) { if (k == 0) { tile(512 + c, u); u.aux = 0 | ((c + 1) << 2); return true; } k -= 1; }
        else if (c < 32) { if (k == 3) { tile(512 + c - 16, u); u.aux = 1 | ((c - 16 + 1) << 2); return true; } if (k > 3) k -= 1; }
        else if (c < 48) { if (k == 6) { tile(512 + c - 32, u); u.aux = 2 | ((c - 32 + 1) << 2); return true; } }
        if (k >= 6) return false;
        tile((long)(k / 3) * G + c, u); u.aux = k % 3; return true;
    }
};

template <class Epi, class Op, class Sched = Order>
__device__ __forceinline__ void gemm_phase(LAS unsigned char* lds, const Op& op, const Sched& S, const Epi& E) {
    const int tid = threadIdx.x, wid = __builtin_amdgcn_readfirstlane(tid >> 6), lane = tid & 63, wr = wid >> 2, wc = wid & 3, fr = lane & 15, fq = lane >> 4;
    const int K = op.K, nt = K / BK;
    unsigned voffA[2], voffB[2];
#pragma unroll
    for (int i = 0; i < 2; ++i) { int R, C; stage_rc(tid * 16 + i * 8192, R, C); const int Rb = Epi::PERM ? ((R & ~31) + perm32(R & 31)) : R;
        const int Ra = Op::SEG ? ((R & 15) * 8 + ((R >> 4) & 3)) : R;
        voffA[i] = (unsigned)(Ra * op.lda + C) * 2u; voffB[i] = (unsigned)(Rb * op.ldb + C) * 2u; }
    const size_t kstep = (size_t)(BK * 2);
    const size_t hstepA = op.hstepA();
    const size_t hstepB = (size_t)HALF * op.ldb * 2;
    const unsigned ldsw = (unsigned)wid * 1024u;
    const int aoff = lds_byte(wr * 64 + fr, fq * 8), boff = lds_byte(wc * 32 + fr, fq * 8);
#define PG8_SA(b, h) (((b) * 2 + (h)) * HTB)
#define PG8_SB(b, h) ((4 + (b) * 2 + (h)) * HTB)
#define PG8_STAGEB(bufoff, gbase) do { _Pragma("unroll") for (int _i = 0; _i < 2; ++_i) \
        __builtin_amdgcn_global_load_lds((const unsigned*)((const char*)(gbase) + voffB[_i]), (LAS unsigned*)(lds + (bufoff) + ldsw + _i * 8192), 16, 0, 0); } while (0)
#define PG8_STAGEA(bufoff, gbase, dlt) do { \
        __builtin_amdgcn_global_load_lds((const unsigned*)((const char*)(gbase) + voffA[0]), (LAS unsigned*)(lds + (bufoff) + ldsw), 16, 0, 0); \
        __builtin_amdgcn_global_load_lds((const unsigned*)((const char*)(gbase) + (dlt) + voffA[1]), (LAS unsigned*)(lds + (bufoff) + ldsw + 8192), 16, 0, 0); } while (0)
#define PG8_LDA(dst, b, h) do { _Pragma("unroll") for (int m = 0; m < 4; ++m) _Pragma("unroll") for (int k = 0; k < 2; ++k) dst[m][k] = *(const LAS bf16x8*)(lds + PG8_SA(b, h) + aoff + m * 2048 + k * 1024); } while (0)
#define PG8_LDB(dst, b, h) do { _Pragma("unroll") for (int n = 0; n < 2; ++n) _Pragma("unroll") for (int k = 0; k < 2; ++k) dst[n][k] = *(const LAS bf16x8*)(lds + PG8_SB(b, h) + boff + n * 2048 + k * 1024); } while (0)
#define PG8_MMA(ai, bj, At, Bt) do { __builtin_amdgcn_s_setprio(1); _Pragma("unroll") for (int m = 0; m < 4; ++m) _Pragma("unroll") for (int n = 0; n < 2; ++n) _Pragma("unroll") for (int k = 0; k < 2; ++k) \
        acc[ai][bj][m][n] = __builtin_amdgcn_mfma_f32_16x16x32_bf16(Bt[n][k], At[m][k], acc[ai][bj][m][n], 0, 0, 0); __builtin_amdgcn_s_setprio(0); } while (0)
#define PG8_WAIT_V(n) asm volatile("s_waitcnt vmcnt(" #n ")" ::: "memory")
#define PG8_WAIT_L(n) asm volatile("s_waitcnt lgkmcnt(" #n ")" ::: "memory")
#define PG8_BAR __builtin_amdgcn_s_barrier()
#define PG8_SCHED __builtin_amdgcn_sched_barrier(0)
    Unit cur, nxt; int ui = 0;
    if (!S.next(0, cur)) return;
    f32x4 acc[2][2][4][2];
#pragma unroll
    for (int a = 0; a < 2; ++a)
#pragma unroll
        for (int b = 0; b < 2; ++b)
#pragma unroll
            for (int m = 0; m < 4; ++m)
#pragma unroll
                for (int n = 0; n < 2; ++n) acc[a][b][m][n] = (f32x4){0.f, 0.f, 0.f, 0.f};
    bf16x8 At[4][2], B0[2][2], B1[2][2];
    const char* cA = op.a_base(cur, 0); const char* cB = op.b_base(cur);
    long dAc = Op::SEG ? (long)(op.a_base(cur, 1) - cA) : 0;
    PG8_STAGEB(PG8_SB(0, 0), cB); PG8_STAGEB(PG8_SB(0, 1), cB + hstepB); PG8_STAGEA(PG8_SA(0, 0), cA, dAc); PG8_STAGEA(PG8_SA(0, 1), cA + hstepA, dAc);
    if (wr == 1) PG8_BAR;
    PG8_WAIT_V(2); PG8_BAR;
    PG8_STAGEB(PG8_SB(1, 0), cB + kstep); PG8_STAGEA(PG8_SA(1, 0), cA + kstep, dAc); PG8_STAGEB(PG8_SB(1, 1), cB + hstepB + kstep);
    PG8_WAIT_V(6); PG8_BAR;
    for (;;) {
        const bool has_next = S.next(ui + 1, nxt);
        const char* nA = has_next ? op.a_base(nxt, 0) : cA; const char* nB = has_next ? op.b_base(nxt) : cB;
        const long dAn = Op::SEG ? (has_next ? (long)(op.a_base(nxt, 1) - nA) : dAc) : 0;
        for (int t = 0; t < nt; t += 2) {
            const bool last = (t == nt - 2);
            const char* a1 = cA + (size_t)(t + 1) * kstep;
            const char* a2 = last ? nA : cA + (size_t)(t + 2) * kstep; const char* b2 = last ? nB : cB + (size_t)(t + 2) * kstep;
            const long d2 = last ? dAn : dAc;
            const char* a3 = a2 + kstep; const char* b3 = b2 + kstep;
            PG8_LDB(B0, 0, 0); PG8_LDB(B1, 0, 1); PG8_SCHED; PG8_LDA(At, 0, 0); PG8_STAGEA(PG8_SA(1, 1), a1 + hstepA, dAc);
            PG8_WAIT_V(8); PG8_WAIT_L(0); PG8_BAR; PG8_MMA(0, 0, At, B0); PG8_MMA(0, 1, At, B1); PG8_BAR; PG8_SCHED;
            PG8_LDA(At, 0, 1); PG8_STAGEB(PG8_SB(0, 0), b2); PG8_STAGEB(PG8_SB(0, 1), b2 + hstepB); PG8_STAGEA(PG8_SA(0, 0), a2, d2);
            PG8_WAIT_V(8); PG8_WAIT_L(0); PG8_BAR; PG8_MMA(1, 0, At, B0); PG8_MMA(1, 1, At, B1); PG8_BAR; PG8_SCHED;
            PG8_LDB(B0, 1, 0); PG8_LDB(B1, 1, 1); PG8_SCHED; PG8_LDA(At, 1, 0); PG8_STAGEA(PG8_SA(0, 1), a2 + hstepA, d2);
            PG8_WAIT_V(8); PG8_WAIT_L(0); PG8_BAR; PG8_MMA(0, 0, At, B0); PG8_MMA(0, 1, At, B1); PG8_BAR; PG8_SCHED;
            PG8_LDA(At, 1, 1); PG8_STAGEB(PG8_SB(1, 0), b3); PG8_STAGEB(PG8_SB(1, 1), b3 + hstepB); PG8_STAGEA(PG8_SA(1, 0), a3, d2);
            PG8_WAIT_V(8); PG8_WAIT_L(0); PG8_BAR; PG8_MMA(1, 0, At, B0); PG8_MMA(1, 1, At, B1); PG8_BAR; PG8_SCHED;
        }
        if (wr == 0) PG8_BAR;
        E(acc, cur, wr, wc, fr, fq);
        if (!has_next) break;
#pragma unroll
        for (int a = 0; a < 2; ++a)
#pragma unroll
            for (int b = 0; b < 2; ++b)
#pragma unroll
                for (int m = 0; m < 4; ++m)
#pragma unroll
                    for (int n = 0; n < 2; ++n) acc[a][b][m][n] = (f32x4){0.f, 0.f, 0.f, 0.f};
        cur = nxt; cA = nA; cB = nB; dAc = dAn; ++ui;
        if (wr == 1) PG8_BAR;
    }
    PG8_WAIT_V(0);
    PG8_BAR;
#undef PG8_SA
#undef PG8_SB
#undef PG8_STAGEA
#undef PG8_STAGEB
#undef PG8_LDA
#undef PG8_LDB
#undef PG8_MMA
#undef PG8_WAIT_V
#undef PG8_WAIT_L
#undef PG8_BAR
#undef PG8_SCHED
}
}
using pg8::Unit; using pg8::Order;

struct OpPlain {
    static constexpr bool SEG = false;
    const bf16_t* A; const bf16_t* Bt; int K, lda, ldb;
    __device__ __forceinline__ const char* a_base(const Unit& u, int) const { return (const char*)(A + (size_t)u.pm * 256 * lda); }
    __device__ __forceinline__ const char* b_base(const Unit& u) const { return (const char*)(Bt + (size_t)u.pn * 256 * ldb); }
    __device__ __forceinline__ size_t hstepA() const { return (size_t)128 * lda * 2; }
};
struct OpMerge {
    static constexpr bool SEG = false;
    const bf16_t* ya; const bf16_t* yb; const bf16_t* yc; const bf16_t* Wt; int K, lda, ldb;
    __device__ __forceinline__ const char* a_base(const Unit& u, int) const { const int nb = u.aux & 3; const bf16_t* A = nb == 0 ? ya : (nb == 1 ? yb : yc); return (const char*)(A + (size_t)u.pm * 256 * 1024); }
    __device__ __forceinline__ const char* b_base(const Unit& u) const { return (const char*)(Wt + ((size_t)(u.aux & 3) * 2048 + (size_t)u.pn * 256) * 1024); }
    __device__ __forceinline__ size_t hstepA() const { return (size_t)128 * 1024 * 2; }
};
__device__ __forceinline__ void attn_decode(int id, int& row0, int& head, int& kvb, int& nvalid) {
    if (id < 256) { const int tile = id >> 2; head = id & 3; row0 = tile * 256; kvb = tile >> 5; nvalid = 256; }
    else { const int j = id - 256; head = j & 3; const int sb = j >> 2; row0 = MP + 32 * sb; kvb = 2 + sb; nvalid = 32; }
}
struct OpAttn {
    static constexpr bool SEG = false;
    const bf16_t* Abuf; const bf16_t* Bp; const bf16_t* Bs; int K, lda, ldb; int pv;
    __device__ __forceinline__ const char* a_base(const Unit& u, int) const { int row0, head, kvb, nv; attn_decode(u.pm, row0, head, kvb, nv); return (const char*)(Abuf + (size_t)row0 * 1024 + head * 256); }
    __device__ __forceinline__ const char* b_base(const Unit& u) const { int row0, head, kvb, nv; attn_decode(u.pm, row0, head, kvb, nv);
        const bf16_t* base = kvb < 2 ? Bp + (size_t)kvb * 262144 : Bs + (size_t)(kvb - 2) * 262144;
        return (const char*)(pv ? base + (size_t)head * 256 * 256 : base + head * 256); }
    __device__ __forceinline__ size_t hstepA() const { return (size_t)128 * 1024 * 2; }
};
__device__ __forceinline__ int seg_base_row(int g) { if (g < 132) { const int b = g / 66, gi = g - 66 * b; return b * SEQ + 126 * gi - 2; } return MP + 128 * (g - 132); }
struct OpUp {
    static constexpr bool SEG = true;
    const bf16_t* A; const bf16_t* Bt; int K, lda, ldb;
    __device__ __forceinline__ const char* a_base(const Unit& u, int piece) const { return (const char*)(A + (long)seg_base_row(2 * u.pm + piece) * lda); }
    __device__ __forceinline__ const char* b_base(const Unit& u) const { return (const char*)(Bt + (size_t)u.pn * 256 * ldb); }
    __device__ __forceinline__ size_t hstepA() const { return (size_t)4 * lda * 2; }
};

typedef f32x4 Acc[2][2][4][2];

struct EpiZ {
    static constexpr bool PERM = true;
    bf16_t* Z;
    __device__ __forceinline__ void operator()(const Acc& acc, const Unit& u, int wr, int wc, int fr, int fq) const {
        const int seg = u.pn >> 2, col0 = (u.pn & 3) * 256 + wc * 32 + 8 * fq; const int row0 = u.pm * 256 + wr * 64 + fr;
        bf16_t* base = Z + (size_t)seg * ((size_t)M * ZW);
#pragma unroll
        for (int ai = 0; ai < 2; ++ai)
#pragma unroll
            for (int m = 0; m < 4; ++m) { bf16_t* rowp = base + (size_t)(row0 + ai * 128 + m * 16) * ZW + col0;
#pragma unroll
                for (int bj = 0; bj < 2; ++bj) *(u32x4*)(rowp + bj * 128) = pack8(acc[ai][bj][m][0], acc[ai][bj][m][1]); }
    }
};
struct EpiKV {
    static constexpr bool PERM = true;
    float* out; bf16_t* kb;
    __device__ __forceinline__ void operator()(const Acc& acc, const Unit& u, int wr, int wc, int fr, int fq) const {
        const bool isv = u.pn >= 4; const int col0 = (u.pn & 3) * 256 + wc * 32 + 8 * fq; const int row0 = u.pm * 256 + wr * 64 + fr;
        float* ob = out + (isv ? O_MV : O_MK);
#pragma unroll
        for (int ai = 0; ai < 2; ++ai)
#pragma unroll
            for (int m = 0; m < 4; ++m) { const size_t ro = (size_t)(row0 + ai * 128 + m * 16) * 1024 + col0;
#pragma unroll
                for (int bj = 0; bj < 2; ++bj) { *(f32x4*)(ob + ro + bj * 128) = acc[ai][bj][m][0]; *(f32x4*)(ob + ro + bj * 128 + 4) = acc[ai][bj][m][1];
                    if (!isv) *(u32x4*)(kb + ro + bj * 128) = pack8(acc[ai][bj][m][0], acc[ai][bj][m][1]); } }
    }
};
struct EpiS {
    static constexpr bool PERM = true;
    bf16_t* P; float* rs;
    __device__ __forceinline__ void operator()(const Acc& acc, const Unit& u, int wr, int wc, int fr, int fq) const {
        int row0, head, kvb, nv; attn_decode(u.pm, row0, head, kvb, nv);
#pragma unroll
        for (int ai = 0; ai < 2; ++ai)
#pragma unroll
            for (int m = 0; m < 4; ++m) { const int rt = ai * 128 + wr * 64 + m * 16 + fr; float s = 0.f; u32x4 w[2];
#pragma unroll
                for (int bj = 0; bj < 2; ++bj) { f32x4 p0, p1;
#pragma unroll
                    for (int j = 0; j < 4; ++j) { p0[j] = __expf(acc[ai][bj][m][0][j] * 0.0625f); p1[j] = __expf(acc[ai][bj][m][1][j] * 0.0625f); }
                    s += (p0[0] + p0[1]) + (p0[2] + p0[3]) + (p1[0] + p1[1]) + (p1[2] + p1[3]); w[bj] = pack8(p0, p1); }
                s += __shfl_xor(s, 16); s += __shfl_xor(s, 32);
                if (rt < nv) { bf16_t* rowp = P + (size_t)(row0 + rt) * 1024 + head * 256 + wc * 32 + 8 * fq;
                    *(u32x4*)rowp = w[0]; *(u32x4*)(rowp + 128) = w[1];
                    if (fq == 0) rs[(size_t)(row0 + rt) * 16 + head * 4 + wc] = s; } }
    }
};
struct EpiPV {
    static constexpr bool PERM = true;
    bf16_t* Y; const float* rs;
    __device__ __forceinline__ void operator()(const Acc& acc, const Unit& u, int wr, int wc, int fr, int fq) const {
        int row0, head, kvb, nv; attn_decode(u.pm, row0, head, kvb, nv);
#pragma unroll
        for (int ai = 0; ai < 2; ++ai)
#pragma unroll
            for (int m = 0; m < 4; ++m) { const int rt = ai * 128 + wr * 64 + m * 16 + fr;
                if (rt < nv) { const f32x4 r4 = *(const f32x4*)(rs + (size_t)(row0 + rt) * 16 + head * 4); const float inv = 1.f / ((r4[0] + r4[1]) + (r4[2] + r4[3]));
                    bf16_t* rowp = Y + (size_t)(row0 + rt) * 1024 + head * 256 + wc * 32 + 8 * fq;
#pragma unroll
                    for (int bj = 0; bj < 2; ++bj) *(u32x4*)(rowp + bj * 128) = pack8(acc[ai][bj][m][0] * inv, acc[ai][bj][m][1] * inv); } }
    }
};
struct EpiMerge {
    static constexpr bool PERM = true;
    const bf16_t* Zg; const float* bgate; bf16_t* MM; unsigned* flags;
    __device__ __forceinline__ void operator()(const Acc& acc, const Unit& u, int wr, int wc, int fr, int fq) const {
        const int nb = u.aux & 3, xj = (u.aux >> 2) - 1;
        if (xj >= 0 && nb > 0) {
            unsigned sp = 0; while (__hip_atomic_load(flags + 64 * xj, __ATOMIC_RELAXED, __HIP_MEMORY_SCOPE_AGENT) < 8u * (unsigned)nb) { __builtin_amdgcn_s_sleep(2); if (++sp > (1u << 22)) break; }
            __builtin_amdgcn_fence(__ATOMIC_ACQUIRE, "agent"); } const bf16_t* gb = Zg + (size_t)(2 * nb + (u.pn >> 2)) * ((size_t)M * ZW);
        const int gcol = (u.pn & 3) * 256 + wc * 32 + 8 * fq, ocol = u.pn * 256 + wc * 32 + 8 * fq; const int row0 = u.pm * 256 + wr * 64 + fr;
        f32x4 bg[2][2];
#pragma unroll
        for (int bj = 0; bj < 2; ++bj) { bg[bj][0] = *(const f32x4*)(bgate + nb * 2048 + ocol + bj * 128); bg[bj][1] = *(const f32x4*)(bgate + nb * 2048 + ocol + bj * 128 + 4); }
#pragma unroll
        for (int am = 0; am < 4; ++am) { const int ai = am >> 1, mb = (am & 1) * 2;
            u32x4 gw[2][2], pw[2][2];
#pragma unroll
            for (int mm = 0; mm < 2; ++mm)
#pragma unroll
                for (int bj = 0; bj < 2; ++bj) { const size_t row = (size_t)(row0 + ai * 128 + (mb + mm) * 16);
                    gw[mm][bj] = *(const u32x4*)(gb + row * ZW + gcol + bj * 128);
                    pw[mm][bj] = nb > 0 ? *(const u32x4*)(MM + row * D + ocol + bj * 128) : (u32x4){0u, 0u, 0u, 0u}; }
#pragma unroll
            for (int mm = 0; mm < 2; ++mm)
#pragma unroll
                for (int bj = 0; bj < 2; ++bj) { const int m = mb + mm; const size_t row = (size_t)(row0 + ai * 128 + m * 16);
                    f32x4 g0, g1, p0, p1; unpack8(gw[mm][bj], g0, g1); unpack8(pw[mm][bj], p0, p1);
#pragma unroll
                    for (int j = 0; j < 4; ++j) { p0[j] += sigm(g0[j] + bg[bj][0][j]) * acc[ai][bj][m][0][j]; p1[j] += sigm(g1[j] + bg[bj][1][j]) * acc[ai][bj][m][1][j]; }
                    *(u32x4*)(MM + row * D + ocol + bj * 128) = pack8(p0, p1); }
        }
        if (xj >= 0 && nb < 2) {
            __builtin_amdgcn_fence(__ATOMIC_RELEASE, "agent"); asm volatile("s_waitcnt vmcnt(0)" ::: "memory");
            if (fr == 0 && fq == 0) __hip_atomic_fetch_add(flags + 64 * xj, 1u, __ATOMIC_RELAXED, __HIP_MEMORY_SCOPE_AGENT); }
    }
};
struct EpiPre {
    static constexpr bool PERM = true;
    bf16_t* Y;
    __device__ __forceinline__ void operator()(const Acc& acc, const Unit& u, int wr, int wc, int fr, int fq) const {
        const int ocol = u.pn * 256 + wc * 32 + 8 * fq; const int row0 = u.pm * 256 + wr * 64 + fr;
#pragma unroll
        for (int ai = 0; ai < 2; ++ai)
#pragma unroll
            for (int m = 0; m < 4; ++m) { const size_t row = (size_t)(row0 + ai * 128 + m * 16);
#pragma unroll
                for (int bj = 0; bj < 2; ++bj) *(u32x4*)(Y + row * D + ocol + bj * 128) = pack8(acc[ai][bj][m][0], acc[ai][bj][m][1]); }
    }
};
struct OpSplit {
    static constexpr bool SEG = false;
    const bf16_t* A; const bf16_t* Bt; int K, lda, ldb;
    __device__ __forceinline__ const char* a_base(const Unit& u, int) const { return (const char*)(A + (size_t)(MP + 256 * (u.pm & 1)) * lda + (size_t)(u.pm >> 1) * K); }
    __device__ __forceinline__ const char* b_base(const Unit& u) const { return (const char*)(Bt + (size_t)u.pn * 256 * ldb + (size_t)(u.pm >> 1) * K); }
    __device__ __forceinline__ size_t hstepA() const { return (size_t)128 * lda * 2; }
};
struct EpiSlab {
    static constexpr bool PERM = true;
    float* slab;
    __device__ __forceinline__ void operator()(const Acc& acc, const Unit& u, int wr, int wc, int fr, int fq) const {
        const int ocol = u.pn * 256 + wc * 32 + 8 * fq; const int row0 = (u.pm >> 1) * 512 + (u.pm & 1) * 256 + wr * 64 + fr;
#pragma unroll
        for (int ai = 0; ai < 2; ++ai)
#pragma unroll
            for (int m = 0; m < 4; ++m) { float* rp = slab + (size_t)(row0 + ai * 128 + m * 16) * D + ocol;
#pragma unroll
                for (int bj = 0; bj < 2; ++bj) { *(f32x4*)(rp + bj * 128) = acc[ai][bj][m][0]; *(f32x4*)(rp + bj * 128 + 4) = acc[ai][bj][m][1]; } }
    }
};
__device__ __forceinline__ float gelu_tanh(float x) { const float y = 1.5957691216f * (x + 0.044715f * x * x * x); return x * __builtin_amdgcn_rcpf(1.f + __expf(-y)); }
__device__ __forceinline__ f32x2 gelu_mul_pk(f32x2 c, f32x2 v) {
    const f32x2 c2 = c * c; const f32x2 t = c * (c2 * (-0.10294324f) + (-2.3022082f));
    f32x2 e; e.x = __builtin_amdgcn_exp2f(t.x); e.y = __builtin_amdgcn_exp2f(t.y);
    const f32x2 d = e + 1.0f; f32x2 r; r.x = __builtin_amdgcn_rcpf(d.x); r.y = __builtin_amdgcn_rcpf(d.y);
    return (c * v) * r;
}
struct EpiUp {
    static constexpr bool PERM = true;
    bf16_t* act; const float* cw; const float* cb; const float* st; float* out; const float* r2;
    __device__ __forceinline__ void operator()(const Acc& acc, const Unit& u, int wr, int wc, int fr, int fq) const {
        const int g = 2 * u.pm + wr; const int col = u.pn * 128 + wc * 32 + 8 * fq;
        const bool smp = g >= 132; const int b = smp ? 0 : g / 66, gi = g - 66 * b; const int s0 = 126 * gi - 2;
        f32x4 w0[2], w1[2], w2[2], bb[2];
#pragma unroll
        for (int n = 0; n < 2; ++n) { w0[n] = *(const f32x4*)(cw + col + 4 * n); w1[n] = *(const f32x4*)(cw + FF + col + 4 * n); w2[n] = *(const f32x4*)(cw + 2 * FF + col + 4 * n); bb[n] = *(const f32x4*)(cb + col + 4 * n); }
        float rr[8];
#pragma unroll
        for (int e = 0; e < 8; ++e) { const int idx = fr * 8 + e; int row = smp ? MP + 128 * (g - 132) + idx : b * SEQ + s0 + idx; row = row < 0 ? 0 : row; rr[e] = r2[row]; }
#pragma unroll
        for (int n = 0; n < 2; ++n) {
            f32x4 um2, um1;
#pragma unroll
            for (int j = 0; j < 4; ++j) { um2[j] = __shfl_up(acc[1][0][2][n][j] * rr[6], 1); um1[j] = __shfl_up(acc[1][0][3][n][j] * rr[7], 1); }
            if (smp) { if ((fr & 3) == 0) { const int sb = 4 * (g - 132) + (fr >> 2); um2 = *(const f32x4*)(st + (size_t)(sb * 2 + 0) * FF + col + 4 * n); um1 = *(const f32x4*)(st + (size_t)(sb * 2 + 1) * FF + col + 4 * n); } }
#pragma unroll
            for (int e = 0; e < 8; ++e) { const int ai = e >> 2, m = e & 3; f32x4 uu = acc[ai][0][m][n] * rr[e]; const f32x4 vv = acc[ai][1][m][n] * rr[e];
                const int idx = fr * 8 + e; bool valid; size_t row;
                if (smp) { valid = true; row = (size_t)(MP + 128 * (g - 132) + idx); }
                else { const int tm = s0 + idx; if (tm < 0) uu = (f32x4){0.f, 0.f, 0.f, 0.f}; valid = (idx >= 2) && (tm < SEQ); row = (size_t)(b * SEQ + tm); }
                f32x4 c = bb[n] + w0[n] * um2 + w1[n] * um1 + w2[n] * uu;
                const f32x2 a01 = gelu_mul_pk((f32x2){c[0], c[1]}, (f32x2){vv[0], vv[1]}), a23 = gelu_mul_pk((f32x2){c[2], c[3]}, (f32x2){vv[2], vv[3]});
                const f32x4 a = (f32x4){a01.x, a01.y, a23.x, a23.y};
                if (valid) { u32x2 w; w.x = cvt_pk_bf16(a[0], a[1]); w.y = cvt_pk_bf16(a[2], a[3]); *(u32x2*)(act + row * FF + col + 4 * n) = w;
                    if (smp) { const int tau = idx & 31; if (tau >= 30) *(f32x4*)(out + O_FCS + (size_t)((4 * (g - 132) + (idx >> 5)) * 2 + (tau - 30)) * FF + col + 4 * n) = uu; }
                    else { const int tm = s0 + idx; if (tm >= SEQ - 2) *(f32x4*)(out + O_FCP + (size_t)(b * 2 + (tm - (SEQ - 2))) * FF + col + 4 * n) = uu; } }
                um2 = um1; um1 = uu; }
        }
    }
};

struct Ctx { LAS unsigned char* lds; int tid, lane, wave, G, bid; const float* const* in; float* out; unsigned char* ws; };

__device__ __forceinline__ void transpose_item(const float* W, int ldw, bf16_t* WT, int ldt, int k0, int n0, int drow0, LAS float* scr, int lane, const float* rscale = nullptr) {
    float tv[32];
#pragma unroll
    for (int i = 0; i < 32; ++i) { const int kk = 2 * i + (lane >> 5); tv[i] = __builtin_nontemporal_load(&W[(size_t)(k0 + kk) * ldw + n0 + (lane & 31)]); }
    if (rscale) {
#pragma unroll
        for (int i = 0; i < 32; ++i) tv[i] *= rscale[k0 + 2 * i + (lane >> 5)]; }
#pragma unroll
    for (int i = 0; i < 32; ++i) { const int kk = 2 * i + (lane >> 5); scr[kk * 33 + (lane & 31)] = tv[i]; }
    asm volatile("s_waitcnt lgkmcnt(0)" ::: "memory");
    const int c = lane & 7;
#pragma unroll
    for (int j = 0; j < 4; ++j) { const int n = (lane >> 3) + 8 * j; const LAS float* s = scr + (8 * c) * 33 + n;
        u32x4 o; o.x = pk2(s[0 * 33], s[1 * 33]); o.y = pk2(s[2 * 33], s[3 * 33]); o.z = pk2(s[4 * 33], s[5 * 33]); o.w = pk2(s[6 * 33], s[7 * 33]);
        *(u32x4*)(WT + (size_t)(drow0 + n) * ldt + k0 + 8 * c) = o; }
    asm volatile("s_waitcnt lgkmcnt(0)" ::: "memory");
}
template <class F> __device__ __forceinline__ void transpose_job(const float* W, int K, int N, bf16_t* WT, int ldt, int r, LAS float* scr, int lane, F dmap, const float* rscale = nullptr) {
    const int nblk = N / 32, kb = r / nblk, nb = r % nblk; transpose_item(W, N, WT, ldt, 64 * kb, 32 * nb, dmap(32 * nb), scr, lane, rscale);
}
__device__ __forceinline__ const float* xrow_ptr(const Ctx& c, int m) { return m < MP ? c.in[0] + (size_t)m * D : c.in[1] + (size_t)(m - MP) * D; }
__device__ __forceinline__ void rms_row_bf16(const float* xrow, const float* g, bf16_t* orow, int lane) {
    const f32x4* xr = (const f32x4*)xrow + lane; f32x4 v[8]; float s = 0.f;
#pragma unroll
    for (int j = 0; j < 8; ++j) { v[j] = __builtin_nontemporal_load(&xr[64 * j]); s += (v[j][0] * v[j][0] + v[j][1] * v[j][1]) + (v[j][2] * v[j][2] + v[j][3] * v[j][3]); }
    const float rs = rsqrtf(wave_sum(s) * (1.f / D) + EPS);
    u32x2* o = (u32x2*)orow + lane;
#pragma unroll
    for (int j = 0; j < 8; ++j) { const f32x4 gg = ((const f32x4*)g)[lane + 64 * j]; u32x2 w; w.x = pk2(v[j][0] * rs * gg[0], v[j][1] * rs * gg[1]); w.y = pk2(v[j][2] * rs * gg[2], v[j][3] * rs * gg[3]); o[64 * j] = w; }
}

__device__ __forceinline__ void prep_late(const Ctx& c, int wv, int nwv) {
    LAS float* scr = (LAS float*)(c.lds + c.wave * 16384);
    constexpr int I_BR = 16 * 64, I_OUT = 32 * 64, I_VS = 4 * 32, I_HG = 2 * 4;
    constexpr int NIT = 3 * I_BR + I_OUT + 16 * I_VS + 128 * I_HG;
    for (int it = wv; it < NIT; it += nwv) {
        int r = it;
        if (r < 3 * I_BR) { const int nb = r / I_BR; transpose_job(c.in[22] + (size_t)nb * 1024 * 2048, 1024, 2048, (bf16_t*)(c.ws + WS_WBR) + (size_t)nb * 2048 * 1024, 1024, r % I_BR, scr, c.lane, [](int n0) { return n0; }); continue; } r -= 3 * I_BR;
        if (r < I_OUT) { transpose_job(c.in[24], 2048, 2048, (bf16_t*)(c.ws + WS_WOUT), 2048, r, scr, c.lane, [](int n0) { return n0; }); continue; } r -= I_OUT;
        if (r < 16 * I_VS) { const int b = r / I_VS; transpose_job(c.in[3] + (size_t)b * 262144, 256, 1024, (bf16_t*)(c.ws + WS_VTS) + (size_t)b * 262144, 256, r % I_VS, scr, c.lane, [](int n0) { return n0; }); continue; } r -= 16 * I_VS;
        { const int sq = r / I_HG; transpose_job(c.in[6] + (size_t)sq * 16384, 128, 128, (bf16_t*)(c.ws + WS_STS) + (size_t)sq * 16384, 128, r % I_HG, scr, c.lane, [](int n0) { return n0; }); }
    }
}
__device__ __forceinline__ void phase_prep(const Ctx& c) {
    LAS float* scr = (LAS float*)(c.lds + c.wave * 16384);
    const int gw = c.bid * 8 + c.wave, NGW = c.G * 8;
    bf16_t* win_t = (bf16_t*)((unsigned char*)c.out + DO_WIN);
    constexpr int I_IN = 32 * 384, I_KV = 32 * 64, I_G = 2;
    constexpr int NIT = I_IN + I_KV + 32 * I_G;
    for (int it = gw; it < NIT; it += NGW) {
        int r = it;
        if (r < I_IN) { transpose_job(c.in[10], 2048, 12288, win_t, 2048, r, scr, c.lane, [](int n0) { if (n0 >= 6144) return n0; const int seg = n0 >> 10; const int ps = seg <= 3 ? seg + 2 : seg - 4; return ps * 1024 + (n0 & 1023); }); continue; } r -= I_IN;
        if (r < I_KV) { transpose_job(c.in[21], 2048, 2048, (bf16_t*)(c.ws + WS_WKV), 2048, r, scr, c.lane, [](int n0) { return n0; }); continue; } r -= I_KV;
        { const int h = r / (2 * I_G), which = (r / I_G) & 1, rr = r % I_G;
          transpose_job(c.in[which ? 15 : 13] + (size_t)h * 4096, 64, 64, (bf16_t*)(c.ws + WS_WG) + (size_t)h * 8192 + which * 4096, 64, rr, scr, c.lane, [](int n0) { return n0; }); }
    }
    bf16_t* xn = (bf16_t*)((unsigned char*)c.out + DO_XN);
    for (int m = gw; m < M + 512; m += NGW) {
        if (m < M) rms_row_bf16(xrow_ptr(c, m), c.in[9], xn + (size_t)m * D, c.lane);
        else rms_row_bf16(c.in[8] + (size_t)(m - M) * D, c.in[20], (bf16_t*)(c.ws + WS_MEMN) + (size_t)(m - M) * D, c.lane);
    }
    { const f32x4* src = (const f32x4*)c.in[2]; u32x2* dst = (u32x2*)(c.ws + WS_KBS); const int n4 = 16 * 256 * 1024 / 4;
      for (int i0 = c.bid * 512 + c.tid; i0 < n4; i0 += 4 * c.G * 512) { f32x4 v[4];
#pragma unroll
          for (int q = 0; q < 4; ++q) { const int i = i0 + q * c.G * 512; v[q] = i < n4 ? __builtin_nontemporal_load(&src[i]) : (f32x4){0.f, 0.f, 0.f, 0.f}; }
#pragma unroll
          for (int q = 0; q < 4; ++q) { const int i = i0 + q * c.G * 512; if (i < n4) { u32x2 w; w.x = pk2(v[q][0], v[q][1]); w.y = pk2(v[q][2], v[q][3]); dst[i] = w; } } } }
}

__device__ __forceinline__ void lru_item(const Ctx& c, int cidx, int h, int mode, LAS unsigned char* wl) {
    int lane = c.lane; asm volatile("" : "+v"(lane));
    const int fr = lane & 15, fq = lane >> 4;
    const bool smp = cidx >= 256; const int sb = cidx - 256; const int cb = cidx >> 7, cc = cidx & 127;
    const int row0 = smp ? MP + 32 * sb : cb * SEQ + 64 * cc; const int len = smp ? 32 : 64;
    const bf16_t* zr = (const bf16_t*)(c.ws + WS_Z + 2 * ZB);
    LAS bf16_t* xt = (LAS bf16_t*)wl;
    { u32x4 v[9];
#pragma unroll
      for (int i = 0; i < 9; ++i) { const int ci = lane + 64 * i, r = ci >> 3, c8 = ci & 7; v[i] = (u32x4){0u, 0u, 0u, 0u};
          const bool halo_special = r < 3 && (smp || cc == 0);
          if (r < len + 3 && !halo_special) v[i] = *(const u32x4*)(zr + (size_t)(row0 - 3 + r) * ZW + 64 * h + 8 * c8);
          if (r < 3 && smp) { const float* st = c.in[5] + (size_t)(sb * 3 + r) * 1024 + 64 * h + 8 * c8; const f32x4 a = *(const f32x4*)st, b = *(const f32x4*)(st + 4); v[i] = (u32x4){pk2(a[0], a[1]), pk2(a[2], a[3]), pk2(b[0], b[1]), pk2(b[2], b[3])}; } }
#pragma unroll
      for (int i = 0; i < 9; ++i) { const int ci = lane + 64 * i, r = ci >> 3, c8 = ci & 7; if (r < 67) *(LAS u32x4*)(xt + r * 72 + 8 * c8) = v[i]; } }
    asm volatile("s_waitcnt lgkmcnt(0)" ::: "memory"); __builtin_amdgcn_wave_barrier();
    { const int ch = 64 * h + lane;
      const float cw0 = c.in[11][ch], cw1 = c.in[11][1024 + ch], cw2 = c.in[11][2048 + ch], cw3 = c.in[11][3072 + ch], cbi = c.in[12][ch];
      float x0 = bf2f(xt[(3 + len - 1) * 72 + lane]), x1 = bf2f(xt[(3 + len - 2) * 72 + lane]), x2 = bf2f(xt[(3 + len - 3) * 72 + lane]);
      if (mode == 1 && (smp || cc == 127)) { float* o = smp ? c.out + O_RCS + (size_t)sb * 3072 + ch : c.out + O_RCP + (size_t)cb * 3072 + ch; o[0] = x2; o[1024] = x1; o[2048] = x0; }
      for (int tb = len - 1; tb >= 0; tb -= 8) { unsigned short rv[8];
#pragma unroll
          for (int i = 0; i < 8; ++i) rv[i] = xt[(tb - i) * 72 + lane];
#pragma unroll
          for (int i = 0; i < 8; ++i) { const float x3 = bf2f(rv[i]);
              xt[(3 + tb - i) * 72 + lane] = (bf16_t)f2bf(cbi + cw0 * x3 + cw1 * x2 + cw2 * x1 + cw3 * x0); x0 = x1; x1 = x2; x2 = x3; } } }
    asm volatile("s_waitcnt lgkmcnt(0)" ::: "memory"); __builtin_amdgcn_wave_barrier();
    const bf16_t* wg = (const bf16_t*)(c.ws + WS_WG) + (size_t)h * 8192;
    bf16x8 wf[8][2];
#pragma unroll
    for (int jt = 0; jt < 8; ++jt)
#pragma unroll
        for (int ks = 0; ks < 2; ++ks) wf[jt][ks] = *(const bf16x8*)(wg + (16 * jt + fr) * 64 + 32 * ks + 8 * fq);
    float sp[4], ba[4], bx[4], hc[4], At[4];
#pragma unroll
    for (int jt = 0; jt < 4; ++jt) { const int cg_ = 64 * h + 16 * jt + fr; const float lam = c.in[17][cg_];
        sp[jt] = -8.f * (lam > 15.f ? __expf(-lam) : log1pf(__expf(-lam)));
        ba[jt] = c.in[14][cg_]; bx[jt] = c.in[16][cg_];
        hc[jt] = mode == 1 ? (smp ? c.in[4][(size_t)sb * 1024 + cg_] : ((const float*)(c.ws + WS_HIN))[(size_t)cidx * 1024 + cg_]) : 0.f; At[jt] = 1.f; }
    bf16_t* ya = (bf16_t*)(c.ws + WS_P);
    const int ntt = len / 16;
    for (int tt = 0; tt < ntt; ++tt) {
        const bf16x8 xb0 = *(const LAS bf16x8*)(xt + (3 + 16 * tt + fr) * 72 + 8 * fq), xb1 = *(const LAS bf16x8*)(xt + (3 + 16 * tt + fr) * 72 + 32 + 8 * fq);
        f32x4 g[8];
#pragma unroll
        for (int jt = 0; jt < 8; ++jt) { g[jt] = (f32x4){0.f, 0.f, 0.f, 0.f}; g[jt] = __builtin_amdgcn_mfma_f32_16x16x32_bf16(xb0, wf[jt][0], g[jt], 0, 0, 0); g[jt] = __builtin_amdgcn_mfma_f32_16x16x32_bf16(xb1, wf[jt][1], g[jt], 0, 0, 0); }
#pragma unroll
        for (int jt = 0; jt < 4; ++jt) {
            float PA[4], PB[4];
#pragma unroll
            for (int j = 0; j < 4; ++j) { const float xv = bf2f(xt[(3 + 16 * tt + 4 * fq + j) * 72 + 16 * jt + fr]);
                const float r = sigm(g[jt][j] + ba[jt]), ig = sigm(g[jt + 4][j] + bx[jt]);
                const float a = __expf(sp[jt] * r); const float b = __builtin_amdgcn_sqrtf(fmaxf(1.f - a * a, 0.f)) * (ig * xv);
                if (j == 0) { PA[0] = a; PB[0] = b; } else { PA[j] = a * PA[j - 1]; PB[j] = a * PB[j - 1] + b; } }
            float TA = PA[3], TB = PB[3];
            { const float pa = __shfl_up(TA, 16), pb = __shfl_up(TB, 16); if (fq >= 1) { TB = TA * pb + TB; TA = TA * pa; } }
            { const float pa = __shfl_up(TA, 32), pb = __shfl_up(TB, 32); if (fq >= 2) { TB = TA * pb + TB; TA = TA * pa; } }
            if (mode == 1) {
                float EA = __shfl_up(TA, 16), EB = __shfl_up(TB, 16); if (fq == 0) { EA = 1.f; EB = 0.f; }
                const float hs = EA * hc[jt] + EB; float hv = 0.f;
#pragma unroll
                for (int j = 0; j < 4; ++j) { hv = PA[j] * hs + PB[j]; ya[(size_t)(row0 + 16 * tt + 4 * fq + j) * ZW + 64 * h + 16 * jt + fr] = (bf16_t)f2bf(hv); }
                hc[jt] = __shfl(hv, 48 + fr);
            } else { const float tA = __shfl(TA, 48 + fr), tB = __shfl(TB, 48 + fr); hc[jt] = tA * hc[jt] + tB; At[jt] *= tA; }
        }
    }
    if (fq == 0) {
#pragma unroll
        for (int jt = 0; jt < 4; ++jt) { const int cg_ = 64 * h + 16 * jt + fr;
            if (mode == 0) { ((float*)(c.ws + WS_AGGA))[(size_t)cidx * 1024 + cg_] = At[jt]; ((float*)(c.ws + WS_AGGB))[(size_t)cidx * 1024 + cg_] = hc[jt]; }
            else if (smp) c.out[O_RHS + (size_t)sb * 1024 + cg_] = hc[jt];
            else if (cc == 127) c.out[O_RHP + (size_t)cb * 1024 + cg_] = hc[jt]; }
    }
    asm volatile("s_waitcnt lgkmcnt(0)" ::: "memory"); __builtin_amdgcn_wave_barrier();
}

struct HgItem { int row0, len, h; };
__device__ __forceinline__ HgItem hg_decode(int it) { HgItem r; if (it < 2048) { const int b = it >> 10, rem = it & 1023; r.row0 = b * SEQ + 64 * (rem >> 3); r.len = 64; r.h = rem & 7; } else { const int j = it - 2048; r.row0 = MP + 32 * (j >> 3); r.len = 32; r.h = j & 7; } return r; }
__device__ __forceinline__ bf16_t* hg_U(const Ctx& c, int it) { return it < 2048 ? (bf16_t*)((unsigned char*)c.out + DO_U) + (size_t)it * 16384 : (bf16_t*)(c.ws + WS_US) + (size_t)(it - 2048) * 16384; }
__device__ __forceinline__ bf16_t* hg_ST(const Ctx& c, int it) { return it < 2048 ? (bf16_t*)((unsigned char*)c.out + DO_ST) + (size_t)it * 16384 : (bf16_t*)(c.ws + WS_STS) + (size_t)(it - 2048) * 16384; }

__device__ __forceinline__ void hg_gates(const Ctx& c, int tid, const HgItem& I, LAS float* psum, float (&g)[16], float (&kk)[16], float& boff, float& btot) {
    const int q = tid >> 7, k = tid & 127; const bf16_t* zf = (const bf16_t*)(c.ws + WS_Z + 4 * ZB);
    const float l0 = c.in[18][I.h * 128 + k], l1 = c.in[18][1024 + I.h * 128 + k]; const float lb = sigm(l0 - l1);
    float s = 0.f;
#pragma unroll
    for (int i = 0; i < 16; ++i) { const int t = 16 * q + i; const bool ok = t < I.len; const int tr = ok ? t : 0;
        const float fr_ = bf2f(zf[(size_t)(I.row0 + tr) * ZW + I.h * 128 + k]); const float f = lb + (1.f - lb) * sigm(fr_);
        const float gv = ok ? __logf(f) : 0.f; g[i] = gv; kk[i] = ok ? 1.f - f : 0.f; s += gv; }
    psum[q * 128 + k] = s;
    __syncthreads();
    const float p0 = psum[k], p1 = psum[128 + k], p2 = psum[256 + k], p3 = psum[384 + k];
    boff = q == 0 ? 0.f : (q == 1 ? p0 : (q == 2 ? p0 + p1 : p0 + p1 + p2)); btot = (p0 + p1) + (p2 + p3);
}
__device__ __forceinline__ void hg_vt_fetch(const Ctx& c, int tid, const HgItem& I, unsigned (&w)[8]) {
    const int q = tid >> 7, v = tid & 127; const bf16_t* zi = (const bf16_t*)(c.ws + WS_Z + 5 * ZB);
#pragma unroll
    for (int i = 0; i < 8; ++i) { const int t = 16 * q + 2 * i; const bool ok = t < I.len; const int tr = ok ? t : 0;
        const unsigned lo = zi[(size_t)(I.row0 + tr) * ZW + I.h * 128 + v], hi = zi[(size_t)(I.row0 + tr + 1) * ZW + I.h * 128 + v];
        w[i] = ok ? (lo | (hi << 16)) : 0u; }
}
__device__ __forceinline__ void hg_vt_store(int tid, LAS bf16_t* VT, const unsigned (&w)[8]) {
    const int q = tid >> 7, v = tid & 127;
    *(LAS u32x4*)(VT + v * 72 + 16 * q) = (u32x4){w[0], w[1], w[2], w[3]}; *(LAS u32x4*)(VT + v * 72 + 16 * q + 8) = (u32x4){w[4], w[5], w[6], w[7]};
}
__device__ __forceinline__ void hg_pass1(const Ctx& c, int it) {
    const HgItem I = hg_decode(it);
    LAS bf16_t* KdT = (LAS bf16_t*)c.lds;
    LAS bf16_t* VT = (LAS bf16_t*)(c.lds + 18432);
    LAS float* psum = (LAS float*)(c.lds + 36864);
    float g[16], kk[16], boff, btot;
    int tid = c.tid; asm volatile("" : "+v"(tid));
    unsigned vw[8]; hg_vt_fetch(c, tid, I, vw);
    hg_gates(c, tid, I, psum, g, kk, boff, btot);
    const int q = tid >> 7, k = tid & 127;
    { float bc = boff; unsigned w[8];
#pragma unroll
      for (int i = 0; i < 8; ++i) { bc += g[2 * i]; const float a = kk[2 * i] * __expf(btot - bc); bc += g[2 * i + 1]; const float b = kk[2 * i + 1] * __expf(btot - bc); w[i] = pk2(a, b); }
      *(LAS u32x4*)(KdT + k * 72 + 16 * q) = (u32x4){w[0], w[1], w[2], w[3]}; *(LAS u32x4*)(KdT + k * 72 + 16 * q + 8) = (u32x4){w[4], w[5], w[6], w[7]}; }
    if (q == 0) ((float*)(c.ws + WS_DBUF))[(size_t)it * 128 + k] = __expf(btot);
    hg_vt_store(tid, VT, vw);
    __syncthreads();
    const int fr = tid & 15, fq = (tid >> 4) & 3, w = c.wave;
    const bf16x8 a0 = *(const LAS bf16x8*)(KdT + (16 * w + fr) * 72 + 8 * fq), a1 = *(const LAS bf16x8*)(KdT + (16 * w + fr) * 72 + 32 + 8 * fq);
    bf16_t* U = hg_U(c, it);
#pragma unroll
    for (int vt = 0; vt < 8; ++vt) {
        const bf16x8 b0 = *(const LAS bf16x8*)(VT + (16 * vt + fr) * 72 + 8 * fq), b1 = *(const LAS bf16x8*)(VT + (16 * vt + fr) * 72 + 32 + 8 * fq);
        f32x4 acc = (f32x4){0.f, 0.f, 0.f, 0.f};
        acc = __builtin_amdgcn_mfma_f32_16x16x32_bf16(a0, b0, acc, 0, 0, 0); acc = __builtin_amdgcn_mfma_f32_16x16x32_bf16(a1, b1, acc, 0, 0, 0);
        u32x2 o; o.x = pk2(acc[0], acc[1]); o.y = pk2(acc[2], acc[3]);
        *(u32x2*)(U + (size_t)(16 * vt + fr) * 128 + 16 * w + 4 * fq) = o;
    }
    __syncthreads();
}
__device__ __forceinline__ void hg_scan(const Ctx& c) {
    const float* dbuf = (const float*)(c.ws + WS_DBUF);
    LAS float* dl = (LAS float*)c.lds;
    for (int p0 = c.bid * 512; p0 < 16 * 8192; p0 += c.G * 512) {
        const int seq = p0 >> 13, b = seq >> 3, h = seq & 7;
        __syncthreads();
        { f32x4 t[8];
#pragma unroll
          for (int i = 0; i < 8; ++i) { const int q = c.tid + 512 * i, ch = q >> 5, k4 = q & 31; t[i] = *(const f32x4*)(dbuf + ((size_t)b * 1024 + ch * 8 + h) * 128 + 4 * k4); }
#pragma unroll
          for (int i = 0; i < 8; ++i) ((LAS f32x4*)dl)[c.tid + 512 * i] = t[i]; }
        __syncthreads();
        const int p = p0 + c.tid, pe = p & 8191, v = pe >> 6, k2 = (pe & 63) * 2;
        float s0 = 0.f, s1 = 0.f;
        const unsigned* __restrict__ Up = (const unsigned*)((unsigned char*)c.out + DO_U); unsigned* __restrict__ Sp = (unsigned*)((unsigned char*)c.out + DO_ST);
        const size_t e0 = ((size_t)b * 1024 + h) * 8192 + (size_t)v * 64 + (k2 >> 1);
        for (int cb0 = 0; cb0 < 128; cb0 += 32) {
            unsigned u[32];
#pragma unroll
            for (int i = 0; i < 32; ++i) u[i] = Up[e0 + (size_t)(cb0 + i) * 65536];
#pragma unroll
            for (int i = 0; i < 32; ++i) { const f32x2 d = *(const LAS f32x2*)(dl + (cb0 + i) * 128 + k2);
                Sp[e0 + (size_t)(cb0 + i) * 65536] = cvt_pk_bf16(s0, s1); s0 = d[0] * s0 + bflo(u[i]); s1 = d[1] * s1 + bfhi(u[i]); }
        }
        float* o = c.out + O_HGP + (size_t)seq * 16384; o[(size_t)k2 * 128 + v] = s0; o[(size_t)(k2 + 1) * 128 + v] = s1;
    }
    __syncthreads();
    for (int p = c.bid * 512 + c.tid; p < 128 * 16384; p += c.G * 512) {
        const int seq = p >> 14, e = p & 16383, k = e >> 7, v = e & 127; const int it = 2048 + seq;
        const float s = c.in[6][p]; const float d = dbuf[(size_t)it * 128 + k]; const float u = bf2f(((const bf16_t*)(c.ws + WS_US))[(size_t)seq * 16384 + v * 128 + k]);
        c.out[O_HGS + p] = d * s + u;
    }
}
__device__ __forceinline__ void hg_pass3(const Ctx& c, int it) {
    const HgItem I = hg_decode(it);
    LAS bf16_t* Q0 = (LAS bf16_t*)c.lds;
    LAS bf16_t* QE = (LAS bf16_t*)(c.lds + 17408);
    LAS bf16_t* KE = (LAS bf16_t*)(c.lds + 34816);
    LAS bf16_t* VT = (LAS bf16_t*)(c.lds + 52224);
    LAS bf16_t* AM = (LAS bf16_t*)(c.lds + 70656);
    LAS bf16_t* STl = (LAS bf16_t*)(c.lds + 79872);
    LAS float* psum = (LAS float*)(c.lds + 114688);
    LAS float* red = (LAS float*)(c.lds + 116736);
    float g[16], kk[16], boff, btot;
    int tid = c.tid; asm volatile("" : "+v"(tid));
    unsigned vw[8]; hg_vt_fetch(c, tid, I, vw);
    u32x4 stv[4]; { const u32x4* src = (const u32x4*)hg_ST(c, it);
#pragma unroll
      for (int i = 0; i < 4; ++i) stv[i] = src[tid + 512 * i]; }
    unsigned short qraw[16]; { const bf16_t* zq = (const bf16_t*)(c.ws + WS_Z + 3 * ZB); const int q_ = tid >> 7, k_ = tid & 127;
#pragma unroll
      for (int i = 0; i < 16; ++i) { const int t = 16 * q_ + i; const int tr = t < I.len ? t : 0; qraw[i] = zq[(size_t)(I.row0 + tr) * ZW + I.h * 128 + k_]; } }
    hg_gates(c, tid, I, psum, g, kk, boff, btot);
    const int q = tid >> 7, k = tid & 127;
    {
      const float p0 = psum[k], p1 = psum[128 + k]; const float ref = I.len == 64 ? p0 + p1 : p0;
      float bc = boff;
#pragma unroll
      for (int i = 0; i < 16; ++i) { const int t = 16 * q + i; bc += g[i]; const bool ok = t < I.len;
          float qv = bf2f(qraw[i]); qv = ok ? qv : 0.f;
          Q0[t * 136 + k] = (bf16_t)f2bf(qv * __expf(bc)); QE[t * 136 + k] = (bf16_t)f2bf(qv * __expf(bc - ref)); KE[t * 136 + k] = (bf16_t)f2bf(kk[i] * __expf(ref - bc)); } }
    hg_vt_store(tid, VT, vw);
    {
#pragma unroll
      for (int i = 0; i < 4; ++i) { const int ci = tid + 512 * i; const int v = ci >> 4, kc = ci & 15; *(LAS u32x4*)(STl + v * 136 + 8 * kc) = stv[i]; } }
    __syncthreads();
    const int fr = tid & 15, fq = (tid >> 4) & 3, w = c.wave;
    { const int tt = w >> 1;
#pragma unroll
      for (int si = 0; si < 2; ++si) { const int st = 2 * (w & 1) + si; f32x4 acc = (f32x4){0.f, 0.f, 0.f, 0.f};
          if (st <= tt) {
#pragma unroll
              for (int ks = 0; ks < 4; ++ks) { const bf16x8 a = *(const LAS bf16x8*)(QE + (16 * tt + fr) * 136 + 32 * ks + 8 * fq), b = *(const LAS bf16x8*)(KE + (16 * st + fr) * 136 + 32 * ks + 8 * fq);
                  acc = __builtin_amdgcn_mfma_f32_16x16x32_bf16(a, b, acc, 0, 0, 0); } }
#pragma unroll
          for (int j = 0; j < 4; ++j) { const int t = 16 * tt + 4 * fq + j, s = 16 * st + fr; AM[t * 72 + s] = (bf16_t)f2bf(s <= t ? acc[j] : 0.f); } } }
    __syncthreads();
    const int tt = w & 3, vh = w >> 2;
    bf16x8 bq[4], ba_[2];
#pragma unroll
    for (int ks = 0; ks < 4; ++ks) bq[ks] = *(const LAS bf16x8*)(Q0 + (16 * tt + fr) * 136 + 32 * ks + 8 * fq);
#pragma unroll
    for (int ks = 0; ks < 2; ++ks) ba_[ks] = *(const LAS bf16x8*)(AM + (16 * tt + fr) * 72 + 32 * ks + 8 * fq);
    f32x4 o[4]; float ss = 0.f;
#pragma unroll
    for (int vi = 0; vi < 4; ++vi) { const int vt = 4 * vh + vi; o[vi] = (f32x4){0.f, 0.f, 0.f, 0.f};
#pragma unroll
        for (int ks = 0; ks < 4; ++ks) { const bf16x8 a = *(const LAS bf16x8*)(STl + (16 * vt + fr) * 136 + 32 * ks + 8 * fq); o[vi] = __builtin_amdgcn_mfma_f32_16x16x32_bf16(a, bq[ks], o[vi], 0, 0, 0); }
#pragma unroll
        for (int ks = 0; ks < 2; ++ks) { const bf16x8 a = *(const LAS bf16x8*)(VT + (16 * vt + fr) * 72 + 32 * ks + 8 * fq); o[vi] = __builtin_amdgcn_mfma_f32_16x16x32_bf16(a, ba_[ks], o[vi], 0, 0, 0); }
        ss += (o[vi][0] * o[vi][0] + o[vi][1] * o[vi][1]) + (o[vi][2] * o[vi][2] + o[vi][3] * o[vi][3]); }
    ss += __shfl_xor(ss, 16); ss += __shfl_xor(ss, 32);
    if (fq == 0) red[vh * 64 + 16 * tt + fr] = ss;
    __syncthreads();
    const int t = 16 * tt + fr;
    if (t < I.len) { const float rs = rsqrtf((red[t] + red[64 + t]) * (1.f / 128.f) + EPS);
        bf16_t* yb = (bf16_t*)(c.ws + WS_Z + 0 * ZB) + (size_t)(I.row0 + t) * ZW + I.h * 128;
#pragma unroll
        for (int vi = 0; vi < 4; ++vi) { const int v0 = 16 * (4 * vh + vi) + 4 * fq; const u32x2 og = *(const u32x2*)(yb + v0); const f32x4 gn = *(const f32x4*)(c.in[19] + v0);
            u32x2 wv; wv.x = pk2(o[vi][0] * rs * gn[0] * sigm(bflo(og.x)), o[vi][1] * rs * gn[1] * sigm(bfhi(og.x))); wv.y = pk2(o[vi][2] * rs * gn[2] * sigm(bflo(og.y)), o[vi][3] * rs * gn[3] * sigm(bfhi(og.y)));
            *(u32x2*)(yb + v0) = wv; } }
    __syncthreads();
}

__device__ __forceinline__ float load_pre_row(const Ctx& c, int m, const bf16_t* Y, const float* slab, int nsl, f32x4 (&y)[8]) {
    float s = 0.f;
    if (m < MP) { const u32x2* yp = (const u32x2*)(Y + (size_t)m * D) + c.lane;
#pragma unroll
        for (int j = 0; j < 8; ++j) { const u32x2 w = __builtin_nontemporal_load(&yp[64 * j]); y[j] = (f32x4){bflo(w.x), bfhi(w.x), bflo(w.y), bfhi(w.y)}; } }
    else {
#pragma unroll
        for (int j = 0; j < 8; ++j) y[j] = (f32x4){0.f, 0.f, 0.f, 0.f};
        for (int sl = 0; sl < nsl; ++sl) { const f32x4* sp = (const f32x4*)(slab + ((size_t)sl * 512 + (m - MP)) * D) + c.lane;
#pragma unroll
            for (int j = 0; j < 8; ++j) y[j] += __builtin_nontemporal_load(&sp[64 * j]); } }
#pragma unroll
    for (int j = 0; j < 8; ++j) s += (y[j][0] * y[j][0] + y[j][1] * y[j][1]) + (y[j][2] * y[j][2] + y[j][3] * y[j][3]);
    return wave_sum(s);
}
__device__ __forceinline__ void phase_norm_mid(const Ctx& c) {
    const int gw = c.bid * 8 + c.wave, NGW = c.G * 8;
    for (int m = gw; m < M; m += NGW) {
        f32x4 y[8]; const float rs = rsqrtf(load_pre_row(c, m, (const bf16_t*)(c.ws + WS_YPRE), (const float*)(c.ws + WS_SLAB6), 8, y) * (1.f / D) + EPS);
        const f32x4* xr = (const f32x4*)xrow_ptr(c, m) + c.lane; float s2 = 0.f;
        u32x2* xf = (u32x2*)((bf16_t*)(c.ws + WS_XF) + (size_t)m * D) + c.lane;
#pragma unroll
        for (int j = 0; j < 8; ++j) { const f32x4 x = __builtin_nontemporal_load(&xr[64 * j]); const f32x4 g = ((const f32x4*)c.in[25])[c.lane + 64 * j];
            y[j] = x + y[j] * rs * g; s2 += (y[j][0] * y[j][0] + y[j][1] * y[j][1]) + (y[j][2] * y[j][2] + y[j][3] * y[j][3]);
            u32x2 w; w.x = cvt_pk_bf16(y[j][0], y[j][1]); w.y = cvt_pk_bf16(y[j][2], y[j][3]); xf[64 * j] = w; }
        const float r2 = rsqrtf(wave_sum(s2) * (1.f / D) + EPS);
        if (c.lane == 0) ((float*)(c.ws + WS_R2))[m] = r2;
    }
}
__device__ __forceinline__ void phase_norm_fin(const Ctx& c) {
    const int gw = c.bid * 8 + c.wave, NGW = c.G * 8;
    for (int m = gw; m < M; m += NGW) {
        f32x4 y[8]; const float rs = rsqrtf(load_pre_row(c, m, (const bf16_t*)(c.ws + WS_YPRE2), (const float*)(c.ws + WS_SLAB9), 11, y) * (1.f / D) + EPS);
        f32x4* o = (f32x4*)(c.out + (size_t)m * D) + c.lane; const u32x2* x1 = (const u32x2*)((const bf16_t*)(c.ws + WS_XF) + (size_t)m * D) + c.lane;
#pragma unroll
        for (int j = 0; j < 8; ++j) { const f32x4 g = ((const f32x4*)c.in[31])[c.lane + 64 * j]; const u32x2 w = __builtin_nontemporal_load(&x1[64 * j]);
            __builtin_nontemporal_store((f32x4){bflo(w.x), bfhi(w.x), bflo(w.y), bfhi(w.y)} + y[j] * rs * g, &o[64 * j]); }
    }
}

#define XB_TMO      128
#define XB_XCNT(j)  (256  + 64 * (j))
#define XB_XSUB(j)  (1280 + 64 * (j))
#define XB_XGEN(j)  (2304 + 64 * (j))
#define XB_TOP      3328
#define XB_TOPGEN   3392
#define XCD_BAR_WORDS 3456
#define XB_SPIN_CAP (1u << 20)
__device__ __forceinline__ unsigned xb_ld(unsigned* p)              { return __hip_atomic_load(p, __ATOMIC_RELAXED, __HIP_MEMORY_SCOPE_AGENT); }
__device__ __forceinline__ unsigned xb_add(unsigned* p, unsigned v) { return __hip_atomic_fetch_add(p, v, __ATOMIC_RELAXED, __HIP_MEMORY_SCOPE_AGENT); }
__device__ __forceinline__ unsigned xb_xcc_id() { return (unsigned)__builtin_amdgcn_s_getreg((3 << 11) | 20) & 0xFu; }
#define XB_SPIN(cond, bar) do { unsigned _sp = 0; while (cond) { __builtin_amdgcn_s_sleep(1); \
    if ((++_sp & 255u) == 0u) { if (xb_ld(&(bar)[XB_TMO])) break; if (_sp > XB_SPIN_CAP) { atomicAdd(&(bar)[XB_TMO], 1u); break; } } } } while (0)
struct XcdBarrier { unsigned* bar; unsigned x; volatile LAS unsigned* st; };
__device__ __forceinline__ XcdBarrier xcd_barrier_post(unsigned* bar, volatile LAS unsigned* st) {
    XcdBarrier b; b.bar = bar; b.x = xb_xcc_id(); b.st = st;
    if (threadIdx.x == 0) (void)xb_add(&bar[XB_XCNT(b.x)], 1u);
    return b;
}
__device__ __forceinline__ void xcd_barrier_complete(unsigned* bar, unsigned x, unsigned& nloc, unsigned& nx) {
    const unsigned G = gridDim.x * gridDim.y * gridDim.z;
    unsigned sum, cnt, mine, sp = 0u;
    for (;;) {
        sum = 0u; cnt = 0u; mine = 0u;
#pragma unroll
        for (unsigned j = 0; j < 16; ++j) { const unsigned c = xb_ld(&bar[XB_XCNT(j)]); sum += c; cnt += (c > 0u) ? 1u : 0u; mine = (j == x) ? c : mine; }
        if (sum == G) break;
        __builtin_amdgcn_s_sleep(1);
        if ((++sp & 255u) == 0u) { if (xb_ld(&bar[XB_TMO])) break; if (sp > XB_SPIN_CAP) { atomicAdd(&bar[XB_TMO], 1u); break; } }
    }
    nloc = mine > 0u ? mine : 1u; nx = cnt > 0u ? cnt : 1u;
}
__device__ __forceinline__ void xcd_barrier(const XcdBarrier& b) {
    asm volatile("s_waitcnt vmcnt(0)" ::: "memory");
    __syncthreads();
    if (threadIdx.x == 0) {
        unsigned* bar = b.bar;
        __builtin_amdgcn_s_waitcnt(0);
        unsigned nloc = b.st[0], nx = b.st[1];
        if (nloc == 0u) { xcd_barrier_complete(bar, b.x, nloc, nx); b.st[0] = nloc; b.st[1] = nx; }
        const unsigned old = xb_add(&bar[XB_XSUB(b.x)], 1u);
        const unsigned gen = old / nloc;
        if (old + 1u == (gen + 1u) * nloc) {
            __builtin_amdgcn_fence(__ATOMIC_RELEASE, "agent");
            asm volatile("s_waitcnt vmcnt(0)" ::: "memory");
            const unsigned og = xb_add(&bar[XB_TOP], 1u);
            const unsigned tg = og / nx;
            if (og + 1u == (tg + 1u) * nx) xb_add(&bar[XB_TOPGEN], 1u);
            else XB_SPIN(xb_ld(&bar[XB_TOPGEN]) == tg, bar);
            __builtin_amdgcn_fence(__ATOMIC_ACQUIRE, "agent");
            xb_add(&bar[XB_XGEN(b.x)], 1u);
            asm volatile("s_waitcnt vmcnt(0)" ::: "memory");
        } else {
            XB_SPIN(xb_ld(&bar[XB_XGEN(b.x)]) == gen, bar);
            __builtin_amdgcn_fence(__ATOMIC_ACQUIRE, "agent");
            asm volatile("s_waitcnt vmcnt(0)" ::: "memory");
        }
    }
    __syncthreads();
}

struct Args { const float* in[32]; float* out; unsigned char* ws; int ph_lo, ph_hi, rep, pad; };

__global__ void __launch_bounds__(512, 2) fwd_kernel(Args args) {
    extern __shared__ __attribute__((aligned(16))) unsigned char lds_raw[];
    Ctx c; c.lds = (LAS unsigned char*)lds_raw; c.tid = threadIdx.x; c.lane = c.tid & 63; c.wave = __builtin_amdgcn_readfirstlane(c.tid >> 6); c.G = gridDim.x; c.bid = blockIdx.x;
    c.in = args.in; c.out = args.out; c.ws = args.ws;
    const int lo = args.ph_lo, hi = args.ph_hi;
#define REP(bit) for (int r_ = 0, n_ = 1 + ((args.rep >> (bit)) & 1); r_ < n_; ++r_)
    const int gw = c.bid * 8 + c.wave, NGW = c.G * 8;
    bf16_t* Z = (bf16_t*)(c.ws + WS_Z);
#ifndef PHMASK
#define PHMASK 0x7ff
#endif
#define IN(k) (((PHMASK >> (k)) & 1) && lo <= (k) && (k) < hi)
#define SEAM(k) do { if (IN(k) && IN((k) + 1)) { xcd_barrier(bar); } } while (0)
    volatile LAS unsigned* misc = (volatile LAS unsigned*)(c.lds + 131072);
    if (c.tid < 8) misc[c.tid] = 0u;
    __syncthreads();
    XcdBarrier bar = xcd_barrier_post((unsigned*)c.ws, misc);
    if (lo < 0) cg::this_grid().sync();

    if (IN(0)) { REP(0) phase_prep(c); }
    SEAM(0);
    if (IN(1)) {
        { OpPlain op{(const bf16_t*)((unsigned char*)c.out + DO_XN), (const bf16_t*)((unsigned char*)c.out + DO_WIN), 2048, 2048, 2048}; Order S; S.init(M / 256, 48, c.G, c.bid, 1, WGM_P1);
          EpiZ E{Z}; pg8::gemm_phase<EpiZ, OpPlain>(c.lds, op, S, E); }
        __syncthreads();
        if (c.G == 256 && c.bid >= 96 && c.bid < c.G - 16) prep_late(c, (c.bid - 96) * 8 + c.wave, 144 * 8);
        else if (c.G != 256) prep_late(c, c.bid * 8 + c.wave, c.G * 8);
        if (c.bid >= c.G - 16) {
          OpPlain op{(const bf16_t*)(c.ws + WS_MEMN), (const bf16_t*)(c.ws + WS_WKV), 2048, 2048, 2048}; Order S; S.init(2, 8, 16, c.bid - (c.G - 16));
          EpiKV E{c.out, (bf16_t*)(c.ws + WS_KBP)}; pg8::gemm_phase<EpiKV, OpPlain>(c.lds, op, S, E); }
    }
    SEAM(1);
    if (IN(2)) {
#if !defined(P2SEL) || P2SEL==0
        { OpAttn op{Z + 1 * (size_t)M * ZW, (const bf16_t*)(c.ws + WS_KBP), (const bf16_t*)(c.ws + WS_KBS), 256, 1024, 1024, 0}; Order S; S.init(320, 1, c.G, c.bid);
          EpiS E{(bf16_t*)(c.ws + WS_P), (float*)(c.ws + WS_RS)}; pg8::gemm_phase<EpiS, OpAttn>(c.lds, op, S, E); }
#endif
        __syncthreads();
        { LAS float* scr = (LAS float*)(c.lds + c.wave * 16384);
          for (int r = gw - 64 * 8; r >= 0 && r < 2 * 128; r += NGW) { const int b = r >> 7; transpose_job(c.out + O_MV + (size_t)b * 262144, 256, 1024, (bf16_t*)(c.ws + WS_VTP) + (size_t)b * 262144, 256, r & 127, scr, c.lane, [](int n0) { return n0; }); } }
        __syncthreads();
#if !defined(P2SEL) || P2SEL==1
        REP(1) for (int it = c.G - 1 - c.bid; it < 2176; it += c.G) hg_pass1(c, it);
#endif
        __syncthreads();
#if !defined(P2SEL) || P2SEL==2
        REP(2) for (int r = gw; r < 256 * 16; r += NGW) lru_item(c, r >> 4, r & 15, 0, c.lds + c.wave * 9728);
#endif
    }
    SEAM(2);
    if (IN(3)) {
        { OpAttn op{(const bf16_t*)(c.ws + WS_P), (const bf16_t*)(c.ws + WS_VTP), (const bf16_t*)(c.ws + WS_VTS), 256, 1024, 256, 1}; Order S; S.init(320, 1, c.G, c.bid);
          EpiPV E{Z + 1 * (size_t)M * ZW, (const float*)(c.ws + WS_RS)}; pg8::gemm_phase<EpiPV, OpAttn>(c.lds, op, S, E); }
        __syncthreads();
        for (int p = (c.G - 1 - c.bid) * 512 + c.tid; p < 2048; p += c.G * 512) { const int b = p >> 10, ch = p & 1023; float h = 0.f;
            const float* A = (const float*)(c.ws + WS_AGGA); const float* B = (const float*)(c.ws + WS_AGGB); float* H = (float*)(c.ws + WS_HIN);
            for (int k0 = 0; k0 < 128; k0 += 16) { float av[16], bv[16];
#pragma unroll
                for (int i = 0; i < 16; ++i) { const size_t e = (size_t)(b * 128 + k0 + i) * 1024 + ch; av[i] = A[e]; bv[i] = B[e]; }
#pragma unroll
                for (int i = 0; i < 16; ++i) { const size_t e = (size_t)(b * 128 + k0 + i) * 1024 + ch; H[e] = h; h = av[i] * h + bv[i]; } } }
        REP(3) hg_scan(c);
    }
    SEAM(3);
    if (IN(4)) {
        for (int it = c.bid; it < 2176; it += c.G) hg_pass3(c, it);
        __syncthreads();
        for (int r = NGW - 1 - gw; r < 272 * 16; r += NGW) lru_item(c, r >> 4, r & 15, 1, c.lds + c.wave * 9728);
    }
    SEAM(4);
    if (IN(5)) {
        const bool conv_first = (c.bid & 1) != 0; const bool full = c.G == 256;
        for (int pass = 0; pass < 2; ++pass) {
            if ((pass == 0) == conv_first) {
                if (!full || c.bid >= 48) {
                  LAS float* scr = (LAS float*)(c.lds + c.wave * 16384); constexpr int I_UP = 32 * 352, I_DN = 88 * 64;
                  const int w0 = full ? (c.bid - 48) * 8 + c.wave : c.bid * 8 + c.wave, nw = full ? (c.G - 48) * 8 : c.G * 8;
                  for (int it = w0; it < (full ? I_UP : I_UP + I_DN); it += nw) {
                      if (it < I_UP) transpose_job(c.in[27], 2048, 11264, (bf16_t*)(c.ws + WS_WUP), 2048, it, scr, c.lane, [](int n0) { const int isv = n0 >= FF, n = isv ? n0 - FF : n0; return (n >> 7) * 256 + isv * 128 + (n & 127); }, c.in[26]);
                      else transpose_job(c.in[30], FF, 2048, (bf16_t*)(c.ws + WS_WDN), FF, it - I_UP, scr, c.lane, [](int n0) { return n0; }); } }
            } else {
                OpMerge op{(const bf16_t*)(c.ws + WS_P), Z + 0 * (size_t)M * ZW, Z + 1 * (size_t)M * ZW, (const bf16_t*)(c.ws + WS_WBR), 1024, 1024, 1024}; pg8::MergeOrder S; S.init(M / 256, 8, c.G, c.bid, pg8::WGM);
                EpiMerge E{Z + 6 * (size_t)M * ZW, c.in[23], (bf16_t*)(c.ws + WS_MM), (unsigned*)c.ws + 4096}; pg8::gemm_phase<EpiMerge, OpMerge, pg8::MergeOrder>(c.lds, op, S, E);
            }
            __syncthreads();
        }
    }
    SEAM(5);
    if (IN(6)) {
        { OpPlain op{(const bf16_t*)(c.ws + WS_MM), (const bf16_t*)(c.ws + WS_WOUT), 2048, 2048, 2048}; Order S; S.init(MP / 256, 8, c.G, c.bid);
          EpiPre E{(bf16_t*)(c.ws + WS_YPRE)}; pg8::gemm_phase<EpiPre, OpPlain>(c.lds, op, S, E); }
        __syncthreads();
        { OpSplit op{(const bf16_t*)(c.ws + WS_MM), (const bf16_t*)(c.ws + WS_WOUT), 256, 2048, 2048}; Order S; S.init(2 * 8, 8, c.G, c.bid);
          EpiSlab E{(float*)(c.ws + WS_SLAB6)}; pg8::gemm_phase<EpiSlab, OpSplit>(c.lds, op, S, E); }
    }
    SEAM(6);
    if (IN(7)) { REP(7) phase_norm_mid(c); }
    SEAM(7);
    if (IN(8)) {
        OpUp op{(const bf16_t*)(c.ws + WS_XF), (const bf16_t*)(c.ws + WS_WUP), 2048, 2048, 2048}; Order S; S.init(68, 44, c.G, c.bid, 1, WGM_P8);
        EpiUp E{(bf16_t*)(c.ws + WS_ACT), c.in[28], c.in[29], c.in[7], c.out, (const float*)(c.ws + WS_R2)}; pg8::gemm_phase<EpiUp, OpUp>(c.lds, op, S, E);
        __syncthreads();
        if (c.G == 256 && c.bid >= 176) {
          LAS float* scr = (LAS float*)(c.lds + c.wave * 16384); constexpr int I_DN = 88 * 64;
          for (int it = (c.bid - 176) * 8 + c.wave; it < I_DN; it += 80 * 8) transpose_job(c.in[30], FF, 2048, (bf16_t*)(c.ws + WS_WDN), FF, it, scr, c.lane, [](int n0) { return n0; }); }
    }
    SEAM(8);
    if (IN(9)) {
        { OpPlain op{(const bf16_t*)(c.ws + WS_ACT), (const bf16_t*)(c.ws + WS_WDN), FF, FF, FF}; Order S; S.init(MP / 256, 8, c.G, c.bid);
          EpiPre E{(bf16_t*)(c.ws + WS_YPRE2)}; pg8::gemm_phase<EpiPre, OpPlain>(c.lds, op, S, E); }
        __syncthreads();
        { OpSplit op{(const bf16_t*)(c.ws + WS_ACT), (const bf16_t*)(c.ws + WS_WDN), 512, FF, FF}; Order S; S.init(2 * 11, 8, c.G, c.bid);
          EpiSlab E{(float*)(c.ws + WS_SLAB9)}; pg8::gemm_phase<EpiSlab, OpSplit>(c.lds, op, S, E); }
    }
    SEAM(9);
    if (IN(10)) { phase_norm_fin(c); }
#undef IN
#undef SEAM
}

extern "C" void kernel_launch(void* const* d_in, const int* in_sizes, int n_in, void* d_out, int out_size, void* d_ws, size_t ws_size, hipStream_t stream) {
    static int grid = 0;
    if (grid == 0) {
        if (n_in != 32 || (size_t)out_size != O_END || ws_size < WS_END) { fprintf(stderr, "kernel_launch: unexpected shapes (n_in %d out %d ws %zu)\n", n_in, out_size, ws_size); grid = -1; return; }
        int dev = 0, cus = 0, per_cu = 0;
        hipGetDevice(&dev); hipDeviceGetAttribute(&cus, hipDeviceAttributeMultiprocessorCount, dev);
        hipFuncSetAttribute((const void*)fwd_kernel, hipFuncAttributeMaxDynamicSharedMemorySize, LDS_BYTES);
        hipOccupancyMaxActiveBlocksPerMultiprocessor(&per_cu, (const void*)fwd_kernel, 512, LDS_BYTES);
        if (per_cu < 1) per_cu = 1;
        grid = cus * 1;
        (void)hipGetLastError();
    }
    if (grid < 0) return;
    if (hipMemsetAsync(d_ws, 0, 32768, stream) != hipSuccess) { fprintf(stderr, "memset failed\n"); return; }
    Args a{};
    for (int i = 0; i < 32; ++i) a.in[i] = (const float*)d_in[i];
    a.out = (float*)d_out; a.ws = (unsigned char*)d_ws;
#if MK_LAUNCHES == 1
    a.ph_lo = 0; a.ph_hi = NPH;
    void* kargs[] = {&a};
    hipError_t e = hipLaunchCooperativeKernel((const void*)fwd_kernel, dim3(grid), dim3(512), kargs, LDS_BYTES, stream);
    if (e != hipSuccess) fprintf(stderr, "cooperative launch failed: %s (grid %d)\n", hipGetErrorString(e), grid);
#else
#ifdef REPMASK
    a.rep = REPMASK;
#endif
    for (int p = 0; p < NPH; ++p) { a.ph_lo = p; a.ph_hi = p + 1; hipLaunchKernelGGL(fwd_kernel, dim3(grid), dim3(512), LDS_BYTES, stream, a);
#ifdef DUPMASK
        if ((DUPMASK >> p) & 1) hipLaunchKernelGGL(fwd_kernel, dim3(grid), dim3(512), LDS_BYTES, stream, a);
#endif
    }
#endif
}
```

```cpp
#include <hip/hip_runtime.h>
#include <hip/hip_cooperative_groups.h>
#include <cstdio>
#include <cstdint>
namespace cg = cooperative_groups;

#ifndef MK_LAUNCHES
#define MK_LAUNCHES 1
#endif

#define LAS __attribute__((address_space(3)))
typedef unsigned short bf16_t;
typedef short bf16x8 __attribute__((ext_vector_type(8)));
typedef float f32x4 __attribute__((ext_vector_type(4)));
typedef float f32x2 __attribute__((ext_vector_type(2)));
typedef unsigned u32x4 __attribute__((ext_vector_type(4)));
typedef unsigned u32x2 __attribute__((ext_vector_type(2)));

constexpr int D = 2048, SEQ = 8192, MP = 16384, MS = 512, M = MP + MS, ZW = 1024, FF = 5632;
constexpr float EPS = 1e-6f;
constexpr size_t MiB = (size_t)1 << 20;
constexpr size_t ZB = (size_t)M * ZW * 2;
constexpr size_t WS_AGGA = 1 * MiB, WS_AGGB = 2 * MiB, WS_HIN = 3 * MiB, WS_DBUF = 4 * MiB, WS_RS = 6 * MiB, WS_SSQ = 8 * MiB, WS_WG = 11 * MiB, WS_US = 12 * MiB;
constexpr size_t WS_Z = 16 * MiB;
constexpr size_t WS_WBR = WS_Z + 12 * ZB;
constexpr size_t WS_WOUT = WS_WBR + 12 * MiB;
constexpr size_t WS_P = WS_WOUT + 8 * MiB;
constexpr size_t WS_KBP = WS_P + ZB;
constexpr size_t WS_VTP = WS_KBP + 1 * MiB;
constexpr size_t WS_KBS = WS_VTP + 1 * MiB;
constexpr size_t WS_VTS = WS_KBS + 8 * MiB;
constexpr size_t WS_WKV = WS_VTS + 8 * MiB;
constexpr size_t WS_MEMN = WS_WKV + 8 * MiB;
constexpr size_t WS_STS = WS_MEMN + 2 * MiB;
constexpr size_t WS_END = WS_STS + 4 * MiB;
constexpr size_t WS_MM = WS_Z + 2 * ZB;
constexpr size_t WS_WUP = WS_Z + 4 * ZB;
constexpr size_t WS_WDN = WS_WUP + 44 * MiB;
constexpr size_t WS_YPRE = WS_Z + 0 * ZB;
constexpr size_t WS_XF = WS_YPRE;
constexpr size_t WS_ACT = WS_Z + 6 * ZB;
constexpr size_t WS_SLAB6 = WS_P;
constexpr size_t WS_SLAB9 = WS_WUP;
constexpr size_t WS_YPRE2 = WS_Z + 2 * ZB;
constexpr size_t WS_R2 = 8 * MiB;
constexpr size_t DO_XN = 0, DO_WIN = 66 * MiB, DO_U = 0, DO_ST = 64 * MiB;
constexpr size_t O_Y = 0, O_MK = (size_t)M * D, O_MV = O_MK + 524288, O_RHP = O_MV + 524288, O_RCP = O_RHP + 2048, O_HGP = O_RCP + 6144, O_FCP = O_HGP + 262144,
                 O_RHS = O_FCP + 22528, O_RCS = O_RHS + 16384, O_HGS = O_RCS + 49152, O_FCS = O_HGS + 2097152, O_END = O_FCS + 180224;

constexpr int LDS_BYTES = 131072 + 1024;
constexpr int NPH = 11;
#define WGM_P1 4
#define WGM_P8 4

__device__ __forceinline__ unsigned f2bf(float f) { unsigned u = __builtin_bit_cast(unsigned, f); return (u + 0x7fffu + ((u >> 16) & 1u)) >> 16; }
__device__ __forceinline__ unsigned pk2(float lo, float hi) { return f2bf(lo) | (f2bf(hi) << 16); }
__device__ __forceinline__ float bf2f(unsigned b) { return __builtin_bit_cast(float, b << 16); }
__device__ __forceinline__ float bflo(unsigned w) { return __builtin_bit_cast(float, w << 16); }
__device__ __forceinline__ float bfhi(unsigned w) { return __builtin_bit_cast(float, w & 0xffff0000u); }
__device__ __forceinline__ float sigm(float x) { return __builtin_amdgcn_rcpf(1.f + __expf(-x)); }
__device__ __forceinline__ float wave_sum(float v) {
#pragma unroll
    for (int o = 1; o < 64; o <<= 1) v += __shfl_xor(v, o);
    return v;
}
__device__ __forceinline__ unsigned cvt_pk_bf16(float lo, float hi) { unsigned r; asm volatile("v_cvt_pk_bf16_f32 %0, %1, %2" : "=v"(r) : "v"(lo), "v"(hi)); return r; }
__device__ __forceinline__ u32x4 pack8(f32x4 a, f32x4 b) { u32x4 w; w.x = cvt_pk_bf16(a[0], a[1]); w.y = cvt_pk_bf16(a[2], a[3]); w.z = cvt_pk_bf16(b[0], b[1]); w.w = cvt_pk_bf16(b[2], b[3]); return w; }
__device__ __forceinline__ void unpack8(u32x4 w, f32x4& a, f32x4& b) { a = (f32x4){bflo(w.x), bfhi(w.x), bflo(w.y), bfhi(w.y)}; b = (f32x4){bflo(w.z), bfhi(w.z), bflo(w.w), bfhi(w.w)}; }

namespace pg8 {
constexpr int BM = 256, BK = 64, HALF = 128, HTB = HALF * BK * 2, STAGE_BYTES = 8 * HTB, NXCD = 8, WGM = 8;
__host__ __device__ __forceinline__ int lds_byte(int r, int c) { const int st = (r >> 4) * 2 + (c >> 5), rr = r & 15, cc = c & 31, ob = rr * 64 + cc * 2; return st * 1024 + (ob ^ (((ob >> 9) & 1) << 5)); }
__host__ __device__ __forceinline__ void stage_rc(int b, int& R, int& C) { const int st = b / 1024, sb = b % 1024, swz = sb ^ (((sb >> 9) & 1) << 5); R = (st >> 1) * 16 + swz / 64; C = (st & 1) * 32 + (swz % 64) / 2; }
__host__ __device__ __forceinline__ int perm32(int rho) { const int n = rho >> 4, i = rho & 15; return 8 * (i >> 2) + 4 * n + (i & 3); }

struct Unit { int pm, pn, aux; };
struct Order {
    int nM, nN, nwg, G, c, rep, wgm;
    __device__ void init(int nM_, int nN_, int G_, int c_, int rep_ = 1, int wgm_ = WGM) { nM = nM_; nN = nN_; nwg = nM * nN; G = G_; c = c_; rep = rep_; wgm = wgm_; }
    __device__ bool next(int i, Unit& u) const {
        const long L = (long)(i / rep) * G + c; if (L >= nwg) return false;
        int wgid = (int)L; { const int q = nwg / NXCD, r = nwg % NXCD, xcd = wgid % NXCD, off = wgid / NXCD; wgid = (xcd < r ? xcd * (q + 1) : r * (q + 1) + (xcd - r) * q) + off; }
        const int nig = wgm * nN, gid = wgid / nig, fm = gid * wgm, gsz = (nM - fm) < wgm ? (nM - fm) : wgm;
        u.pm = fm + ((wgid % nig) % gsz); u.pn = (wgid % nig) / gsz; u.aux = i % rep; return true;
    }
};

struct MergeOrder {
    int nM, nN, nwg, G, c, wgm;
    __device__ void init(int nM_, int nN_, int G_, int c_, int wgm_) { nM = nM_; nN = nN_; nwg = nM * nN; G = G_; c = c_; wgm = wgm_; }
    __device__ void tile(long L, Unit& u) const {
        int wgid = (int)L; { const int q = nwg / NXCD, r = nwg % NXCD, xcd = wgid % NXCD, off = wgid / NXCD; wgid = (xcd < r ? xcd * (q + 1) : r * (q + 1) + (xcd - r) * q) + off; }
        const int nig = wgm * nN, gid = wgid / nig, fm = gid * wgm, gsz = (nM - fm) < wgm ? (nM - fm) : wgm;
        u.pm = fm + ((wgid % nig) % gsz); u.pn = (wgid % nig) / gsz;
    }
    __device__ bool next(int i, Unit& u) const {
        if (G != 256 || nwg != 528) { const long L = (long)(i / 3) * G + c; if (L >= nwg) return false; tile(L, u); u.aux = i % 3; return true; }
        int k = i;
        if (c < 16) { if (k == 0) { tile(512 + c, u); u.aux = 0 | ((c + 1) << 2); return true; } k -= 1; }
        else if (c < 32) { if (k == 3) { tile(512 + c - 16, u); u.aux = 1 | ((c - 16 + 1) << 2); return true; } if (k > 3) k -= 1; }
        else if (c < 48) { if (k == 6) { tile(512 + c - 32, u); u.aux = 2 | ((c - 32 + 1) << 2); return true; } }
        if (k >= 6) return false;
        tile((long)(k / 3) * G + c, u); u.aux = k % 3; return true;
    }
};

template <class Epi, class Op, class Sched = Order>
__device__ __forceinline__ void gemm_phase(LAS unsigned char* lds, const Op& op, const Sched& S, const Epi& E) {
    const int tid = threadIdx.x, wid = __builtin_amdgcn_readfirstlane(tid >> 6), lane = tid & 63, wr = wid >> 2, wc = wid & 3, fr = lane & 15, fq = lane >> 4;
    const int K = op.K, nt = K / BK;
    unsigned voffA[2], voffB[2];
#pragma unroll
    for (int i = 0; i < 2; ++i) { int R, C; stage_rc(tid * 16 + i * 8192, R, C); const int Rb = Epi::PERM ? ((R & ~31) + perm32(R & 31)) : R;
        const int Ra = Op::SEG ? ((R & 15) * 8 + ((R >> 4) & 3)) : R;
        voffA[i] = (unsigned)(Ra * op.lda + C) * 2u; voffB[i] = (unsigned)(Rb * op.ldb + C) * 2u; }
    const size_t kstep = (size_t)(BK * 2);
    const size_t hstepA = op.hstepA();
    const size_t hstepB = (size_t)HALF * op.ldb * 2;
    const unsigned ldsw = (unsigned)wid * 1024u;
    const int aoff = lds_byte(wr * 64 + fr, fq * 8), boff = lds_byte(wc * 32 + fr, fq * 8);
#define PG8_SA(b, h) (((b) * 2 + (h)) * HTB)
#define PG8_SB(b, h) ((4 + (b) * 2 + (h)) * HTB)
#define PG8_STAGEB(bufoff, gbase) do { _Pragma("unroll") for (int _i = 0; _i < 2; ++_i) \
        __builtin_amdgcn_global_load_lds((const unsigned*)((const char*)(gbase) + voffB[_i]), (LAS unsigned*)(lds + (bufoff) + ldsw + _i * 8192), 16, 0, 0); } while (0)
#define PG8_STAGEA(bufoff, gbase, dlt) do { \
        __builtin_amdgcn_global_load_lds((const unsigned*)((const char*)(gbase) + voffA[0]), (LAS unsigned*)(lds + (bufoff) + ldsw), 16, 0, 0); \
        __builtin_amdgcn_global_load_lds((const unsigned*)((const char*)(gbase) + (dlt) + voffA[1]), (LAS unsigned*)(lds + (bufoff) + ldsw + 8192), 16, 0, 0); } while (0)
#define PG8_LDA(dst, b, h) do { _Pragma("unroll") for (int m = 0; m < 4; ++m) _Pragma("unroll") for (int k = 0; k < 2; ++k) dst[m][k] = *(const LAS bf16x8*)(lds + PG8_SA(b, h) + aoff + m * 2048 + k * 1024); } while (0)
#define PG8_LDB(dst, b, h) do { _Pragma("unroll") for (int n = 0; n < 2; ++n) _Pragma("unroll") for (int k = 0; k < 2; ++k) dst[n][k] = *(const LAS bf16x8*)(lds + PG8_SB(b, h) + boff + n * 2048 + k * 1024); } while (0)
#define PG8_MMA(ai, bj, At, Bt) do { __builtin_amdgcn_s_setprio(1); _Pragma("unroll") for (int m = 0; m < 4; ++m) _Pragma("unroll") for (int n = 0; n < 2; ++n) _Pragma("unroll") for (int k = 0; k < 2; ++k) \
        acc[ai][bj][m][n] = __builtin_amdgcn_mfma_f32_16x16x32_bf16(Bt[n][k], At[m][k], acc[ai][bj][m][n], 0, 0, 0); __builtin_amdgcn_s_setprio(0); } while (0)
#define PG8_WAIT_V(n) asm volatile("s_waitcnt vmcnt(" #n ")" ::: "memory")
#define PG8_WAIT_L(n) asm volatile("s_waitcnt lgkmcnt(" #n ")" ::: "memory")
#define PG8_BAR __builtin_amdgcn_s_barrier()
#define PG8_SCHED __builtin_amdgcn_sched_barrier(0)
    Unit cur, nxt; int ui = 0;
    if (!S.next(0, cur)) return;
    f32x4 acc[2][2][4][2];
#pragma unroll
    for (int a = 0; a < 2; ++a)
#pragma unroll
        for (int b = 0; b < 2; ++b)
#pragma unroll
            for (int m = 0; m < 4; ++m)
#pragma unroll
                for (int n = 0; n < 2; ++n) acc[a][b][m][n] = (f32x4){0.f, 0.f, 0.f, 0.f};
    bf16x8 At[4][2], B0[2][2], B1[2][2];
    const char* cA = op.a_base(cur, 0); const char* cB = op.b_base(cur);
    long dAc = Op::SEG ? (long)(op.a_base(cur, 1) - cA) : 0;
    PG8_STAGEB(PG8_SB(0, 0), cB); PG8_STAGEB(PG8_SB(0, 1), cB + hstepB); PG8_STAGEA(PG8_SA(0, 0), cA, dAc); PG8_STAGEA(PG8_SA(0, 1), cA + hstepA, dAc);
    if (wr == 1) PG8_BAR;
    PG8_WAIT_V(2); PG8_BAR;
    PG8_STAGEB(PG8_SB(1, 0), cB + kstep); PG8_STAGEA(PG8_SA(1, 0), cA + kstep, dAc); PG8_STAGEB(PG8_SB(1, 1), cB + hstepB + kstep);
    PG8_WAIT_V(6); PG8_BAR;
    for (;;) {
        const bool has_next = S.next(ui + 1, nxt);
        const char* nA = has_next ? op.a_base(nxt, 0) : cA; const char* nB = has_next ? op.b_base(nxt) : cB;
        const long dAn = Op::SEG ? (has_next ? (long)(op.a_base(nxt, 1) - nA) : dAc) : 0;
        for (int t = 0; t < nt; t += 2) {
            const bool last = (t == nt - 2);
            const char* a1 = cA + (size_t)(t + 1) * kstep;
            const char* a2 = last ? nA : cA + (size_t)(t + 2) * kstep; const char* b2 = last ? nB : cB + (size_t)(t + 2) * kstep;
            const long d2 = last ? dAn : dAc;
            const char* a3 = a2 + kstep; const char* b3 = b2 + kstep;
            PG8_LDB(B0, 0, 0); PG8_LDB(B1, 0, 1); PG8_SCHED; PG8_LDA(At, 0, 0); PG8_STAGEA(PG8_SA(1, 1), a1 + hstepA, dAc);
            PG8_WAIT_V(8); PG8_WAIT_L(0); PG8_BAR; PG8_MMA(0, 0, At, B0); PG8_MMA(0, 1, At, B1); PG8_BAR; PG8_SCHED;
            PG8_LDA(At, 0, 1); PG8_STAGEB(PG8_SB(0, 0), b2); PG8_STAGEB(PG8_SB(0, 1), b2 + hstepB); PG8_STAGEA(PG8_SA(0, 0), a2, d2);
            PG8_WAIT_V(8); PG8_WAIT_L(0); PG8_BAR; PG8_MMA(1, 0, At, B0); PG8_MMA(1, 1, At, B1); PG8_BAR; PG8_SCHED;
            PG8_LDB(B0, 1, 0); PG8_LDB(B1, 1, 1); PG8_SCHED; PG8_LDA(At, 1, 0); PG8_STAGEA(PG8_SA(0, 1), a2 + hstepA, d2);
            PG8_WAIT_V(8); PG8_WAIT_L(0); PG8_BAR; PG8_MMA(0, 0, At, B0); PG8_MMA(0, 1, At, B1); PG8_BAR; PG8_SCHED;
            PG8_LDA(At, 1, 1); PG8_STAGEB(PG8_SB(1, 0), b3); PG8_STAGEB(PG8_SB(1, 1), b3 + hstepB); PG8_STAGEA(PG8_SA(1, 0), a3, d2);
            PG8_WAIT_V(8); PG8_WAIT_L(0); PG8_BAR; PG8_MMA(1, 0, At, B0); PG8_MMA(1, 1, At, B1); PG8_BAR; PG8_SCHED;
        }
        if (wr == 0) PG8_BAR;
        E(acc, cur, wr, wc, fr, fq);
        if (!has_next) break;
#pragma unroll
        for (int a = 0; a < 2; ++a)
#pragma unroll
            for (int b = 0; b < 2; ++b)
#pragma unroll
                for (int m = 0; m < 4; ++m)
#pragma unroll
                    for (int n = 0; n < 2; ++n) acc[a][b][m][n] = (f32x4){0.f, 0.f, 0.f, 0.f};
        cur = nxt; cA = nA; cB = nB; dAc = dAn; ++ui;
        if (wr == 1) PG8_BAR;
    }
    PG8_WAIT_V(0);
    PG8_BAR;
#undef PG8_SA
#undef PG8_SB
#undef PG8_STAGEA
#undef PG8_STAGEB
#undef PG8_LDA
#undef PG8_LDB
#undef PG8_MMA
#undef PG8_WAIT_V
#undef PG8_WAIT_L
#undef PG8_BAR
#undef PG8_SCHED
}
}
using pg8::Unit; using pg8::Order;

struct OpPlain {
    static constexpr bool SEG = false;
    const bf16_t* A; const bf16_t* Bt; int K, lda, ldb;
    __device__ __forceinline__ const char* a_base(const Unit& u, int) const { return (const char*)(A + (size_t)u.pm * 256 * lda); }
    __device__ __forceinline__ const char* b_base(const Unit& u) const { return (const char*)(Bt + (size_t)u.pn * 256 * ldb); }
    __device__ __forceinline__ size_t hstepA() const { return (size_t)128 * lda * 2; }
};
struct OpMerge {
    static constexpr bool SEG = false;
    const bf16_t* ya; const bf16_t* yb; const bf16_t* yc; const bf16_t* Wt; int K, lda, ldb;
    __device__ __forceinline__ const char* a_base(const Unit& u, int) const { const int nb = u.aux & 3; const bf16_t* A = nb == 0 ? ya : (nb == 1 ? yb : yc); return (const char*)(A + (size_t)u.pm * 256 * 1024); }
    __device__ __forceinline__ const char* b_base(const Unit& u) const { return (const char*)(Wt + ((size_t)(u.aux & 3) * 2048 + (size_t)u.pn * 256) * 1024); }
    __device__ __forceinline__ size_t hstepA() const { return (size_t)128 * 1024 * 2; }
};
__device__ __forceinline__ void attn_decode(int id, int& row0, int& head, int& kvb, int& nvalid) {
    if (id < 256) { const int tile = id >> 2; head = id & 3; row0 = tile * 256; kvb = tile >> 5; nvalid = 256; }
    else { const int j = id - 256; head = j & 3; const int sb = j >> 2; row0 = MP + 32 * sb; kvb = 2 + sb; nvalid = 32; }
}
struct OpAttn {
    static constexpr bool SEG = false;
    const bf16_t* Abuf; const bf16_t* Bp; const bf16_t* Bs; int K, lda, ldb; int pv;
    __device__ __forceinline__ const char* a_base(const Unit& u, int) const { int row0, head, kvb, nv; attn_decode(u.pm, row0, head, kvb, nv); return (const char*)(Abuf + (size_t)row0 * 1024 + head * 256); }
    __device__ __forceinline__ const char* b_base(const Unit& u) const { int row0, head, kvb, nv; attn_decode(u.pm, row0, head, kvb, nv);
        const bf16_t* base = kvb < 2 ? Bp + (size_t)kvb * 262144 : Bs + (size_t)(kvb - 2) * 262144;
        return (const char*)(pv ? base + (size_t)head * 256 * 256 : base + head * 256); }
    __device__ __forceinline__ size_t hstepA() const { return (size_t)128 * 1024 * 2; }
};
__device__ __forceinline__ int seg_base_row(int g) { if (g < 132) { const int b = g / 66, gi = g - 66 * b; return b * SEQ + 126 * gi - 2; } return MP + 128 * (g - 132); }
struct OpUp {
    static constexpr bool SEG = true;
    const bf16_t* A; const bf16_t* Bt; int K, lda, ldb;
    __device__ __forceinline__ const char* a_base(const Unit& u, int piece) const { return (const char*)(A + (long)seg_base_row(2 * u.pm + piece) * lda); }
    __device__ __forceinline__ const char* b_base(const Unit& u) const { return (const char*)(Bt + (size_t)u.pn * 256 * ldb); }
    __device__ __forceinline__ size_t hstepA() const { return (size_t)4 * lda * 2; }
};

typedef f32x4 Acc[2][2][4][2];

struct EpiZ {
    static constexpr bool PERM = true;
    bf16_t* Z;
    __device__ __forceinline__ void operator()(const Acc& acc, const Unit& u, int wr, int wc, int fr, int fq) const {
        const int seg = u.pn >> 2, col0 = (u.pn & 3) * 256 + wc * 32 + 8 * fq; const int row0 = u.pm * 256 + wr * 64 + fr;
        bf16_t* base = Z + (size_t)seg * ((size_t)M * ZW);
#pragma unroll
        for (int ai = 0; ai < 2; ++ai)
#pragma unroll
            for (int m = 0; m < 4; ++m) { bf16_t* rowp = base + (size_t)(row0 + ai * 128 + m * 16) * ZW + col0;
#pragma unroll
                for (int bj = 0; bj < 2; ++bj) *(u32x4*)(rowp + bj * 128) = pack8(acc[ai][bj][m][0], acc[ai][bj][m][1]); }
    }
};
struct EpiKV {
    static constexpr bool PERM = true;
    float* out; bf16_t* kb;
    __device__ __forceinline__ void operator()(const Acc& acc, const Unit& u, int wr, int wc, int fr, int fq) const {
        const bool isv = u.pn >= 4; const int col0 = (u.pn & 3) * 256 + wc * 32 + 8 * fq; const int row0 = u.pm * 256 + wr * 64 + fr;
        float* ob = out + (isv ? O_MV : O_MK);
#pragma unroll
        for (int ai = 0; ai < 2; ++ai)
#pragma unroll
            for (int m = 0; m < 4; ++m) { const size_t ro = (size_t)(row0 + ai * 128 + m * 16) * 1024 + col0;
#pragma unroll
                for (int bj = 0; bj < 2; ++bj) { *(f32x4*)(ob + ro + bj * 128) = acc[ai][bj][m][0]; *(f32x4*)(ob + ro + bj * 128 + 4) = acc[ai][bj][m][1];
                    if (!isv) *(u32x4*)(kb + ro + bj * 128) = pack8(acc[ai][bj][m][0], acc[ai][bj][m][1]); } }
    }
};
struct EpiS {
    static constexpr bool PERM = true;
    bf16_t* P; float* rs;
    __device__ __forceinline__ void operator()(const Acc& acc, const Unit& u, int wr, int wc, int fr, int fq) const {
        int row0, head, kvb, nv; attn_decode(u.pm, row0, head, kvb, nv);
#pragma unroll
        for (int ai = 0; ai < 2; ++ai)
#pragma unroll
            for (int m = 0; m < 4; ++m) { const int rt = ai * 128 + wr * 64 + m * 16 + fr; float s = 0.f; u32x4 w[2];
#pragma unroll
                for (int bj = 0; bj < 2; ++bj) { f32x4 p0, p1;
#pragma unroll
                    for (int j = 0; j < 4; ++j) { p0[j] = __expf(acc[ai][bj][m][0][j] * 0.0625f); p1[j] = __expf(acc[ai][bj][m][1][j] * 0.0625f); }
                    s += (p0[0] + p0[1]) + (p0[2] + p0[3]) + (p1[0] + p1[1]) + (p1[2] + p1[3]); w[bj] = pack8(p0, p1); }
                s += __shfl_xor(s, 16); s += __shfl_xor(s, 32);
                if (rt < nv) { bf16_t* rowp = P + (size_t)(row0 + rt) * 1024 + head * 256 + wc * 32 + 8 * fq;
                    *(u32x4*)rowp = w[0]; *(u32x4*)(rowp + 128) = w[1];
                    if (fq == 0) rs[(size_t)(row0 + rt) * 16 + head * 4 + wc] = s; } }
    }
};
struct EpiPV {
    static constexpr bool PERM = true;
    bf16_t* Y; const float* rs;
    __device__ __forceinline__ void operator()(const Acc& acc, const Unit& u, int wr, int wc, int fr, int fq) const {
        int row0, head, kvb, nv; attn_decode(u.pm, row0, head, kvb, nv);
#pragma unroll
        for (int ai = 0; ai < 2; ++ai)
#pragma unroll
            for (int m = 0; m < 4; ++m) { const int rt = ai * 128 + wr * 64 + m * 16 + fr;
                if (rt < nv) { const f32x4 r4 = *(const f32x4*)(rs + (size_t)(row0 + rt) * 16 + head * 4); const float inv = 1.f / ((r4[0] + r4[1]) + (r4[2] + r4[3]));
                    bf16_t* rowp = Y + (size_t)(row0 + rt) * 1024 + head * 256 + wc * 32 + 8 * fq;
#pragma unroll
                    for (int bj = 0; bj < 2; ++bj) *(u32x4*)(rowp + bj * 128) = pack8(acc[ai][bj][m][0] * inv, acc[ai][bj][m][1] * inv); } }
    }
};
struct EpiMerge {
    static constexpr bool PERM = true;
    const bf16_t* Zg; const float* bgate; bf16_t* MM; unsigned* flags;
    __device__ __forceinline__ void operator()(const Acc& acc, const Unit& u, int wr, int wc, int fr, int fq) const {
        const int nb = u.aux & 3, xj = (u.aux >> 2) - 1;
        if (xj >= 0 && nb > 0) {
            unsigned sp = 0; while (__hip_atomic_load(flags + 64 * xj, __ATOMIC_RELAXED, __HIP_MEMORY_SCOPE_AGENT) < 8u * (unsigned)nb) { __builtin_amdgcn_s_sleep(2); if (++sp > (1u << 22)) break; }
            __builtin_amdgcn_fence(__ATOMIC_ACQUIRE, "agent"); } const bf16_t* gb = Zg + (size_t)(2 * nb + (u.pn >> 2)) * ((size_t)M * ZW);
        const int gcol = (u.pn & 3) * 256 + wc * 32 + 8 * fq, ocol = u.pn * 256 + wc * 32 + 8 * fq; const int row0 = u.pm * 256 + wr * 64 + fr;
        f32x4 bg[2][2];
#pragma unroll
        for (int bj = 0; bj < 2; ++bj) { bg[bj][0] = *(const f32x4*)(bgate + nb * 2048 + ocol + bj * 128); bg[bj][1] = *(const f32x4*)(bgate + nb * 2048 + ocol + bj * 128 + 4); }
#pragma unroll
        for (int am = 0; am < 4; ++am) { const int ai = am >> 1, mb = (am & 1) * 2;
            u32x4 gw[2][2], pw[2][2];
#pragma unroll
            for (int mm = 0; mm < 2; ++mm)
#pragma unroll
                for (int bj = 0; bj < 2; ++bj) { const size_t row = (size_t)(row0 + ai * 128 + (mb + mm) * 16);
                    gw[mm][bj] = __builtin_nontemporal_load((const u32x4*)(gb + row * ZW + gcol + bj * 128));
                    pw[mm][bj] = nb > 0 ? *(const u32x4*)(MM + row * D + ocol + bj * 128) : (u32x4){0u, 0u, 0u, 0u}; }
#pragma unroll
            for (int mm = 0; mm < 2; ++mm)
#pragma unroll
                for (int bj = 0; bj < 2; ++bj) { const int m = mb + mm; const size_t row = (size_t)(row0 + ai * 128 + m * 16);
                    f32x4 g0, g1, p0, p1; unpack8(gw[mm][bj], g0, g1); unpack8(pw[mm][bj], p0, p1);
#pragma unroll
                    for (int j = 0; j < 4; ++j) { p0[j] += sigm(g0[j] + bg[bj][0][j]) * acc[ai][bj][m][0][j]; p1[j] += sigm(g1[j] + bg[bj][1][j]) * acc[ai][bj][m][1][j]; }
                    *(u32x4*)(MM + row * D + ocol + bj * 128) = pack8(p0, p1); }
        }
        if (xj >= 0 && nb < 2) {
            __builtin_amdgcn_fence(__ATOMIC_RELEASE, "agent"); asm volatile("s_waitcnt vmcnt(0)" ::: "memory");
            if (fr == 0 && fq == 0) __hip_atomic_fetch_add(flags + 64 * xj, 1u, __ATOMIC_RELAXED, __HIP_MEMORY_SCOPE_AGENT); }
    }
};
struct EpiPre {
    static constexpr bool PERM = true;
    bf16_t* Y;
    __device__ __forceinline__ void operator()(const Acc& acc, const Unit& u, int wr, int wc, int fr, int fq) const {
        const int ocol = u.pn * 256 + wc * 32 + 8 * fq; const int row0 = u.pm * 256 + wr * 64 + fr;
#pragma unroll
        for (int ai = 0; ai < 2; ++ai)
#pragma unroll
            for (int m = 0; m < 4; ++m) { const size_t row = (size_t)(row0 + ai * 128 + m * 16);
#pragma unroll
                for (int bj = 0; bj < 2; ++bj) *(u32x4*)(Y + row * D + ocol + bj * 128) = pack8(acc[ai][bj][m][0], acc[ai][bj][m][1]); }
    }
};
struct OpSplit {
    static constexpr bool SEG = false;
    const bf16_t* A; const bf16_t* Bt; int K, lda, ldb;
    __device__ __forceinline__ const char* a_base(const Unit& u, int) const { return (const char*)(A + (size_t)(MP + 256 * (u.pm & 1)) * lda + (size_t)(u.pm >> 1) * K); }
    __device__ __forceinline__ const char* b_base(const Unit& u) const { return (const char*)(Bt + (size_t)u.pn * 256 * ldb + (size_t)(u.pm >> 1) * K); }
    __device__ __forceinline__ size_t hstepA() const { return (size_t)128 * lda * 2; }
};
struct EpiSlab {
    static constexpr bool PERM = true;
    float* slab;
    __device__ __forceinline__ void operator()(const Acc& acc, const Unit& u, int wr, int wc, int fr, int fq) const {
        const int ocol = u.pn * 256 + wc * 32 + 8 * fq; const int row0 = (u.pm >> 1) * 512 + (u.pm & 1) * 256 + wr * 64 + fr;
#pragma unroll
        for (int ai = 0; ai < 2; ++ai)
#pragma unroll
            for (int m = 0; m < 4; ++m) { float* rp = slab + (size_t)(row0 + ai * 128 + m * 16) * D + ocol;
#pragma unroll
                for (int bj = 0; bj < 2; ++bj) { *(f32x4*)(rp + bj * 128) = acc[ai][bj][m][0]; *(f32x4*)(rp + bj * 128 + 4) = acc[ai][bj][m][1]; } }
    }
};
__device__ __forceinline__ float gelu_tanh(float x) { const float y = 1.5957691216f * (x + 0.044715f * x * x * x); return x * __builtin_amdgcn_rcpf(1.f + __expf(-y)); }
__device__ __forceinline__ f32x2 gelu_mul_pk(f32x2 c, f32x2 v) {
    const f32x2 c2 = c * c; const f32x2 t = c * (c2 * (-0.10294324f) + (-2.3022082f));
    f32x2 e; e.x = __builtin_amdgcn_exp2f(t.x); e.y = __builtin_amdgcn_exp2f(t.y);
    const f32x2 d = e + 1.0f; f32x2 r; r.x = __builtin_amdgcn_rcpf(d.x); r.y = __builtin_amdgcn_rcpf(d.y);
    return (c * v) * r;
}
struct EpiUp {
    static constexpr bool PERM = true;
    bf16_t* act; const float* cw; const float* cb; const float* st; float* out; const float* r2;
    __device__ __forceinline__ void operator()(const Acc& acc, const Unit& u, int wr, int wc, int fr, int fq) const {
        const int g = 2 * u.pm + wr; const int col = u.pn * 128 + wc * 32 + 8 * fq;
        const bool smp = g >= 132; const int b = smp ? 0 : g / 66, gi = g - 66 * b; const int s0 = 126 * gi - 2;
        f32x4 w0[2], w1[2], w2[2], bb[2];
#pragma unroll
        for (int n = 0; n < 2; ++n) { w0[n] = *(const f32x4*)(cw + col + 4 * n); w1[n] = *(const f32x4*)(cw + FF + col + 4 * n); w2[n] = *(const f32x4*)(cw + 2 * FF + col + 4 * n); bb[n] = *(const f32x4*)(cb + col + 4 * n); }
        float rr[8];
#pragma unroll
        for (int e = 0; e < 8; ++e) { const int idx = fr * 8 + e; int row = smp ? MP + 128 * (g - 132) + idx : b * SEQ + s0 + idx; row = row < 0 ? 0 : row; rr[e] = r2[row]; }
#pragma unroll
        for (int n = 0; n < 2; ++n) {
            f32x4 um2, um1;
#pragma unroll
            for (int j = 0; j < 4; ++j) { um2[j] = __shfl_up(acc[1][0][2][n][j] * rr[6], 1); um1[j] = __shfl_up(acc[1][0][3][n][j] * rr[7], 1); }
            if (smp) { if ((fr & 3) == 0) { const int sb = 4 * (g - 132) + (fr >> 2); um2 = *(const f32x4*)(st + (size_t)(sb * 2 + 0) * FF + col + 4 * n); um1 = *(const f32x4*)(st + (size_t)(sb * 2 + 1) * FF + col + 4 * n); } }
#pragma unroll
            for (int e = 0; e < 8; ++e) { const int ai = e >> 2, m = e & 3; f32x4 uu = acc[ai][0][m][n] * rr[e]; const f32x4 vv = acc[ai][1][m][n] * rr[e];
                const int idx = fr * 8 + e; bool valid; size_t row;
                if (smp) { valid = true; row = (size_t)(MP + 128 * (g - 132) + idx); }
                else { const int tm = s0 + idx; if (tm < 0) uu = (f32x4){0.f, 0.f, 0.f, 0.f}; valid = (idx >= 2) && (tm < SEQ); row = (size_t)(b * SEQ + tm); }
                f32x4 c = bb[n] + w0[n] * um2 + w1[n] * um1 + w2[n] * uu;
                const f32x2 a01 = gelu_mul_pk((f32x2){c[0], c[1]}, (f32x2){vv[0], vv[1]}), a23 = gelu_mul_pk((f32x2){c[2], c[3]}, (f32x2){vv[2], vv[3]});
                const f32x4 a = (f32x4){a01.x, a01.y, a23.x, a23.y};
                if (valid) { u32x2 w; w.x = cvt_pk_bf16(a[0], a[1]); w.y = cvt_pk_bf16(a[2], a[3]); *(u32x2*)(act + row * FF + col + 4 * n) = w;
                    if (smp) { const int tau = idx & 31; if (tau >= 30) *(f32x4*)(out + O_FCS + (size_t)((4 * (g - 132) + (idx >> 5)) * 2 + (tau - 30)) * FF + col + 4 * n) = uu; }
                    else { const int tm = s0 + idx; if (tm >= SEQ - 2) *(f32x4*)(out + O_FCP + (size_t)(b * 2 + (tm - (SEQ - 2))) * FF + col + 4 * n) = uu; } }
                um2 = um1; um1 = uu; }
        }
    }
};

struct Ctx { LAS unsigned char* lds; int tid, lane, wave, G, bid; const float* const* in; float* out; unsigned char* ws; };

__device__ __forceinline__ void transpose_item(const float* W, int ldw, bf16_t* WT, int ldt, int k0, int n0, int drow0, LAS float* scr, int lane, const float* rscale = nullptr) {
    float tv[32];
#pragma unroll
    for (int i = 0; i < 32; ++i) { const int kk = 2 * i + (lane >> 5); tv[i] = __builtin_nontemporal_load(&W[(size_t)(k0 + kk) * ldw + n0 + (lane & 31)]); }
    if (rscale) {
#pragma unroll
        for (int i = 0; i < 32; ++i) tv[i] *= rscale[k0 + 2 * i + (lane >> 5)]; }
#pragma unroll
    for (int i = 0; i < 32; ++i) { const int kk = 2 * i + (lane >> 5); scr[kk * 33 + (lane & 31)] = tv[i]; }
    asm volatile("s_waitcnt lgkmcnt(0)" ::: "memory");
    const int c = lane & 7;
#pragma unroll
    for (int j = 0; j < 4; ++j) { const int n = (lane >> 3) + 8 * j; const LAS float* s = scr + (8 * c) * 33 + n;
        u32x4 o; o.x = pk2(s[0 * 33], s[1 * 33]); o.y = pk2(s[2 * 33], s[3 * 33]); o.z = pk2(s[4 * 33], s[5 * 33]); o.w = pk2(s[6 * 33], s[7 * 33]);
        *(u32x4*)(WT + (size_t)(drow0 + n) * ldt + k0 + 8 * c) = o; }
    asm volatile("s_waitcnt lgkmcnt(0)" ::: "memory");
}
template <class F> __device__ __forceinline__ void transpose_job(const float* W, int K, int N, bf16_t* WT, int ldt, int r, LAS float* scr, int lane, F dmap, const float* rscale = nullptr) {
    const int nblk = N / 32, kb = r / nblk, nb = r % nblk; transpose_item(W, N, WT, ldt, 64 * kb, 32 * nb, dmap(32 * nb), scr, lane, rscale);
}
__device__ __forceinline__ const float* xrow_ptr(const Ctx& c, int m) { return m < MP ? c.in[0] + (size_t)m * D : c.in[1] + (size_t)(m - MP) * D; }
__device__ __forceinline__ void rms_row_bf16(const float* xrow, const float* g, bf16_t* orow, int lane) {
    const f32x4* xr = (const f32x4*)xrow + lane; f32x4 v[8]; float s = 0.f;
#pragma unroll
    for (int j = 0; j < 8; ++j) { v[j] = __builtin_nontemporal_load(&xr[64 * j]); s += (v[j][0] * v[j][0] + v[j][1] * v[j][1]) + (v[j][2] * v[j][2] + v[j][3] * v[j][3]); }
    const float rs = rsqrtf(wave_sum(s) * (1.f / D) + EPS);
    u32x2* o = (u32x2*)orow + lane;
#pragma unroll
    for (int j = 0; j < 8; ++j) { const f32x4 gg = ((const f32x4*)g)[lane + 64 * j]; u32x2 w; w.x = pk2(v[j][0] * rs * gg[0], v[j][1] * rs * gg[1]); w.y = pk2(v[j][2] * rs * gg[2], v[j][3] * rs * gg[3]); o[64 * j] = w; }
}

__device__ __forceinline__ void prep_late(const Ctx& c, int wv, int nwv) {
    LAS float* scr = (LAS float*)(c.lds + c.wave * 16384);
    constexpr int I_BR = 16 * 64, I_OUT = 32 * 64, I_VS = 4 * 32, I_HG = 2 * 4;
    constexpr int NIT = 3 * I_BR + I_OUT + 16 * I_VS + 128 * I_HG;
    for (int it = wv; it < NIT; it += nwv) {
        int r = it;
        if (r < 3 * I_BR) { const int nb = r / I_BR; transpose_job(c.in[22] + (size_t)nb * 1024 * 2048, 1024, 2048, (bf16_t*)(c.ws + WS_WBR) + (size_t)nb * 2048 * 1024, 1024, r % I_BR, scr, c.lane, [](int n0) { return n0; }); continue; } r -= 3 * I_BR;
        if (r < I_OUT) { transpose_job(c.in[24], 2048, 2048, (bf16_t*)(c.ws + WS_WOUT), 2048, r, scr, c.lane, [](int n0) { return n0; }); continue; } r -= I_OUT;
        if (r < 16 * I_VS) { const int b = r / I_VS; transpose_job(c.in[3] + (size_t)b * 262144, 256, 1024, (bf16_t*)(c.ws + WS_VTS) + (size_t)b * 262144, 256, r % I_VS, scr, c.lane, [](int n0) { return n0; }); continue; } r -= 16 * I_VS;
        { const int sq = r / I_HG; transpose_job(c.in[6] + (size_t)sq * 16384, 128, 128, (bf16_t*)(c.ws + WS_STS) + (size_t)sq * 16384, 128, r % I_HG, scr, c.lane, [](int n0) { return n0; }); }
    }
}
__device__ __forceinline__ void phase_prep(const Ctx& c) {
    LAS float* scr = (LAS float*)(c.lds + c.wave * 16384);
    const int gw = c.bid * 8 + c.wave, NGW = c.G * 8;
    bf16_t* win_t = (bf16_t*)((unsigned char*)c.out + DO_WIN);
    constexpr int I_IN = 32 * 384, I_KV = 32 * 64, I_G = 2;
    constexpr int NIT = I_IN + I_KV + 32 * I_G;
    for (int it = gw; it < NIT; it += NGW) {
        int r = it;
        if (r < I_IN) { transpose_job(c.in[10], 2048, 12288, win_t, 2048, r, scr, c.lane, [](int n0) { if (n0 >= 6144) return n0; const int seg = n0 >> 10; const int ps = seg <= 3 ? seg + 2 : seg - 4; return ps * 1024 + (n0 & 1023); }); continue; } r -= I_IN;
        if (r < I_KV) { transpose_job(c.in[21], 2048, 2048, (bf16_t*)(c.ws + WS_WKV), 2048, r, scr, c.lane, [](int n0) { return n0; }); continue; } r -= I_KV;
        { const int h = r / (2 * I_G), which = (r / I_G) & 1, rr = r % I_G;
          transpose_job(c.in[which ? 15 : 13] + (size_t)h * 4096, 64, 64, (bf16_t*)(c.ws + WS_WG) + (size_t)h * 8192 + which * 4096, 64, rr, scr, c.lane, [](int n0) { return n0; }); }
    }
    bf16_t* xn = (bf16_t*)((unsigned char*)c.out + DO_XN);
    for (int m = gw; m < M + 512; m += NGW) {
        if (m < M) rms_row_bf16(xrow_ptr(c, m), c.in[9], xn + (size_t)m * D, c.lane);
        else rms_row_bf16(c.in[8] + (size_t)(m - M) * D, c.in[20], (bf16_t*)(c.ws + WS_MEMN) + (size_t)(m - M) * D, c.lane);
    }
    { const f32x4* src = (const f32x4*)c.in[2]; u32x2* dst = (u32x2*)(c.ws + WS_KBS); const int n4 = 16 * 256 * 1024 / 4;
      for (int i0 = c.bid * 512 + c.tid; i0 < n4; i0 += 4 * c.G * 512) { f32x4 v[4];
#pragma unroll
          for (int q = 0; q < 4; ++q) { const int i = i0 + q * c.G * 512; v[q] = i < n4 ? __builtin_nontemporal_load(&src[i]) : (f32x4){0.f, 0.f, 0.f, 0.f}; }
#pragma unroll
          for (int q = 0; q < 4; ++q) { const int i = i0 + q * c.G * 512; if (i < n4) { u32x2 w; w.x = pk2(v[q][0], v[q][1]); w.y = pk2(v[q][2], v[q][3]); dst[i] = w; } } } }
}

__device__ __forceinline__ void lru_item(const Ctx& c, int cidx, int h, int mode, LAS unsigned char* wl) {
    int lane = c.lane; asm volatile("" : "+v"(lane));
    const int fr = lane & 15, fq = lane >> 4;
    const bool smp = cidx >= 256; const int sb = cidx - 256; const int cb = cidx >> 7, cc = cidx & 127;
    const int row0 = smp ? MP + 32 * sb : cb * SEQ + 64 * cc; const int len = smp ? 32 : 64;
    const bf16_t* zr = (const bf16_t*)(c.ws + WS_Z + 2 * ZB);
    LAS bf16_t* xt = (LAS bf16_t*)wl;
    { u32x4 v[9];
#pragma unroll
      for (int i = 0; i < 9; ++i) { const int ci = lane + 64 * i, r = ci >> 3, c8 = ci & 7; v[i] = (u32x4){0u, 0u, 0u, 0u};
          const bool halo_special = r < 3 && (smp || cc == 0);
          if (r < len + 3 && !halo_special) v[i] = *(const u32x4*)(zr + (size_t)(row0 - 3 + r) * ZW + 64 * h + 8 * c8);
          if (r < 3 && smp) { const float* st = c.in[5] + (size_t)(sb * 3 + r) * 1024 + 64 * h + 8 * c8; const f32x4 a = *(const f32x4*)st, b = *(const f32x4*)(st + 4); v[i] = (u32x4){pk2(a[0], a[1]), pk2(a[2], a[3]), pk2(b[0], b[1]), pk2(b[2], b[3])}; } }
#pragma unroll
      for (int i = 0; i < 9; ++i) { const int ci = lane + 64 * i, r = ci >> 3, c8 = ci & 7; if (r < 67) *(LAS u32x4*)(xt + r * 72 + 8 * c8) = v[i]; } }
    asm volatile("s_waitcnt lgkmcnt(0)" ::: "memory"); __builtin_amdgcn_wave_barrier();
    { const int ch = 64 * h + lane;
      const float cw0 = c.in[11][ch], cw1 = c.in[11][1024 + ch], cw2 = c.in[11][2048 + ch], cw3 = c.in[11][3072 + ch], cbi = c.in[12][ch];
      float x0 = bf2f(xt[(3 + len - 1) * 72 + lane]), x1 = bf2f(xt[(3 + len - 2) * 72 + lane]), x2 = bf2f(xt[(3 + len - 3) * 72 + lane]);
      if (mode == 1 && (smp || cc == 127)) { float* o = smp ? c.out + O_RCS + (size_t)sb * 3072 + ch : c.out + O_RCP + (size_t)cb * 3072 + ch; o[0] = x2; o[1024] = x1; o[2048] = x0; }
      for (int tb = len - 1; tb >= 0; tb -= 8) { unsigned short rv[8];
#pragma unroll
          for (int i = 0; i < 8; ++i) rv[i] = xt[(tb - i) * 72 + lane];
#pragma unroll
          for (int i = 0; i < 8; ++i) { const float x3 = bf2f(rv[i]);
              xt[(3 + tb - i) * 72 + lane] = (bf16_t)f2bf(cbi + cw0 * x3 + cw1 * x2 + cw2 * x1 + cw3 * x0); x0 = x1; x1 = x2; x2 = x3; } } }
    asm volatile("s_waitcnt lgkmcnt(0)" ::: "memory"); __builtin_amdgcn_wave_barrier();
    const bf16_t* wg = (const bf16_t*)(c.ws + WS_WG) + (size_t)h * 8192;
    bf16x8 wf[8][2];
#pragma unroll
    for (int jt = 0; jt < 8; ++jt)
#pragma unroll
        for (int ks = 0; ks < 2; ++ks) wf[jt][ks] = *(const bf16x8*)(wg + (16 * jt + fr) * 64 + 32 * ks + 8 * fq);
    float sp[4], ba[4], bx[4], hc[4], At[4];
#pragma unroll
    for (int jt = 0; jt < 4; ++jt) { const int cg_ = 64 * h + 16 * jt + fr; const float lam = c.in[17][cg_];
        sp[jt] = -8.f * (lam > 15.f ? __expf(-lam) : log1pf(__expf(-lam)));
        ba[jt] = c.in[14][cg_]; bx[jt] = c.in[16][cg_];
        hc[jt] = mode == 1 ? (smp ? c.in[4][(size_t)sb * 1024 + cg_] : ((const float*)(c.ws + WS_HIN))[(size_t)cidx * 1024 + cg_]) : 0.f; At[jt] = 1.f; }
    bf16_t* ya = (bf16_t*)(c.ws + WS_P);
    const int ntt = len / 16;
    for (int tt = 0; tt < ntt; ++tt) {
        const bf16x8 xb0 = *(const LAS bf16x8*)(xt + (3 + 16 * tt + fr) * 72 + 8 * fq), xb1 = *(const LAS bf16x8*)(xt + (3 + 16 * tt + fr) * 72 + 32 + 8 * fq);
        f32x4 g[8];
#pragma unroll
        for (int jt = 0; jt < 8; ++jt) { g[jt] = (f32x4){0.f, 0.f, 0.f, 0.f}; g[jt] = __builtin_amdgcn_mfma_f32_16x16x32_bf16(xb0, wf[jt][0], g[jt], 0, 0, 0); g[jt] = __builtin_amdgcn_mfma_f32_16x16x32_bf16(xb1, wf[jt][1], g[jt], 0, 0, 0); }
#pragma unroll
        for (int jt = 0; jt < 4; ++jt) {
            float PA[4], PB[4];
#pragma unroll
            for (int j = 0; j < 4; ++j) { const float xv = bf2f(xt[(3 + 16 * tt + 4 * fq + j) * 72 + 16 * jt + fr]);
                const float r = sigm(g[jt][j] + ba[jt]), ig = sigm(g[jt + 4][j] + bx[jt]);
                const float a = __expf(sp[jt] * r); const float b = __builtin_amdgcn_sqrtf(fmaxf(1.f - a * a, 0.f)) * (ig * xv);
                if (j == 0) { PA[0] = a; PB[0] = b; } else { PA[j] = a * PA[j - 1]; PB[j] = a * PB[j - 1] + b; } }
            float TA = PA[3], TB = PB[3];
            { const float pa = __shfl_up(TA, 16), pb = __shfl_up(TB, 16); if (fq >= 1) { TB = TA * pb + TB; TA = TA * pa; } }
            { const float pa = __shfl_up(TA, 32), pb = __shfl_up(TB, 32); if (fq >= 2) { TB = TA * pb + TB; TA = TA * pa; } }
            if (mode == 1) {
                float EA = __shfl_up(TA, 16), EB = __shfl_up(TB, 16); if (fq == 0) { EA = 1.f; EB = 0.f; }
                const float hs = EA * hc[jt] + EB; float hv = 0.f;
#pragma unroll
                for (int j = 0; j < 4; ++j) { hv = PA[j] * hs + PB[j]; ya[(size_t)(row0 + 16 * tt + 4 * fq + j) * ZW + 64 * h + 16 * jt + fr] = (bf16_t)f2bf(hv); }
                hc[jt] = __shfl(hv, 48 + fr);
            } else { const float tA = __shfl(TA, 48 + fr), tB = __shfl(TB, 48 + fr); hc[jt] = tA * hc[jt] + tB; At[jt] *= tA; }
        }
    }
    if (fq == 0) {
#pragma unroll
        for (int jt = 0; jt < 4; ++jt) { const int cg_ = 64 * h + 16 * jt + fr;
            if (mode == 0) { ((float*)(c.ws + WS_AGGA))[(size_t)cidx * 1024 + cg_] = At[jt]; ((float*)(c.ws + WS_AGGB))[(size_t)cidx * 1024 + cg_] = hc[jt]; }
            else if (smp) c.out[O_RHS + (size_t)sb * 1024 + cg_] = hc[jt];
            else if (cc == 127) c.out[O_RHP + (size_t)cb * 1024 + cg_] = hc[jt]; }
    }
    asm volatile("s_waitcnt lgkmcnt(0)" ::: "memory"); __builtin_amdgcn_wave_barrier();
}

struct HgItem { int row0, len, h; };
__device__ __forceinline__ HgItem hg_decode(int it) { HgItem r; if (it < 2048) { const int b = it >> 10, rem = it & 1023; r.row0 = b * SEQ + 64 * (rem >> 3); r.len = 64; r.h = rem & 7; } else { const int j = it - 2048; r.row0 = MP + 32 * (j >> 3); r.len = 32; r.h = j & 7; } return r; }
__device__ __forceinline__ bf16_t* hg_U(const Ctx& c, int it) { return it < 2048 ? (bf16_t*)((unsigned char*)c.out + DO_U) + (size_t)it * 16384 : (bf16_t*)(c.ws + WS_US) + (size_t)(it - 2048) * 16384; }
__device__ __forceinline__ bf16_t* hg_ST(const Ctx& c, int it) { return it < 2048 ? (bf16_t*)((unsigned char*)c.out + DO_ST) + (size_t)it * 16384 : (bf16_t*)(c.ws + WS_STS) + (size_t)(it - 2048) * 16384; }

__device__ __forceinline__ void hg_gates(const Ctx& c, int tid, const HgItem& I, LAS float* psum, float (&g)[16], float (&kk)[16], float& boff, float& btot) {
    const int q = tid >> 7, k = tid & 127; const bf16_t* zf = (const bf16_t*)(c.ws + WS_Z + 4 * ZB);
    const float l0 = c.in[18][I.h * 128 + k], l1 = c.in[18][1024 + I.h * 128 + k]; const float lb = sigm(l0 - l1);
    float s = 0.f;
#pragma unroll
    for (int i = 0; i < 16; ++i) { const int t = 16 * q + i; const bool ok = t < I.len; const int tr = ok ? t : 0;
        const float fr_ = bf2f(zf[(size_t)(I.row0 + tr) * ZW + I.h * 128 + k]); const float f = lb + (1.f - lb) * sigm(fr_);
        const float gv = ok ? __logf(f) : 0.f; g[i] = gv; kk[i] = ok ? 1.f - f : 0.f; s += gv; }
    psum[q * 128 + k] = s;
    __syncthreads();
    const float p0 = psum[k], p1 = psum[128 + k], p2 = psum[256 + k], p3 = psum[384 + k];
    boff = q == 0 ? 0.f : (q == 1 ? p0 : (q == 2 ? p0 + p1 : p0 + p1 + p2)); btot = (p0 + p1) + (p2 + p3);
}
__device__ __forceinline__ void hg_vt_fetch(const Ctx& c, int tid, const HgItem& I, unsigned (&w)[8]) {
    const int q = tid >> 7, v = tid & 127; const bf16_t* zi = (const bf16_t*)(c.ws + WS_Z + 5 * ZB);
#pragma unroll
    for (int i = 0; i < 8; ++i) { const int t = 16 * q + 2 * i; const bool ok = t < I.len; const int tr = ok ? t : 0;
        const unsigned lo = zi[(size_t)(I.row0 + tr) * ZW + I.h * 128 + v], hi = zi[(size_t)(I.row0 + tr + 1) * ZW + I.h * 128 + v];
        w[i] = ok ? (lo | (hi << 16)) : 0u; }
}
__device__ __forceinline__ void hg_vt_store(int tid, LAS bf16_t* VT, const unsigned (&w)[8]) {
    const int q = tid >> 7, v = tid & 127;
    *(LAS u32x4*)(VT + v * 72 + 16 * q) = (u32x4){w[0], w[1], w[2], w[3]}; *(LAS u32x4*)(VT + v * 72 + 16 * q + 8) = (u32x4){w[4], w[5], w[6], w[7]};
}
__device__ __forceinline__ void hg_pass1(const Ctx& c, int it) {
    const HgItem I = hg_decode(it);
    LAS bf16_t* KdT = (LAS bf16_t*)c.lds;
    LAS bf16_t* VT = (LAS bf16_t*)(c.lds + 18432);
    LAS float* psum = (LAS float*)(c.lds + 36864);
    float g[16], kk[16], boff, btot;
    int tid = c.tid; asm volatile("" : "+v"(tid));
    unsigned vw[8]; hg_vt_fetch(c, tid, I, vw);
    hg_gates(c, tid, I, psum, g, kk, boff, btot);
    const int q = tid >> 7, k = tid & 127;
    { float bc = boff; unsigned w[8];
#pragma unroll
      for (int i = 0; i < 8; ++i) { bc += g[2 * i]; const float a = kk[2 * i] * __expf(btot - bc); bc += g[2 * i + 1]; const float b = kk[2 * i + 1] * __expf(btot - bc); w[i] = pk2(a, b); }
      *(LAS u32x4*)(KdT + k * 72 + 16 * q) = (u32x4){w[0], w[1], w[2], w[3]}; *(LAS u32x4*)(KdT + k * 72 + 16 * q + 8) = (u32x4){w[4], w[5], w[6], w[7]}; }
    if (q == 0) ((float*)(c.ws + WS_DBUF))[(size_t)it * 128 + k] = __expf(btot);
    hg_vt_store(tid, VT, vw);
    __syncthreads();
    const int fr = tid & 15, fq = (tid >> 4) & 3, w = c.wave;
    const bf16x8 a0 = *(const LAS bf16x8*)(KdT + (16 * w + fr) * 72 + 8 * fq), a1 = *(const LAS bf16x8*)(KdT + (16 * w + fr) * 72 + 32 + 8 * fq);
    bf16_t* U = hg_U(c, it);
#pragma unroll
    for (int vt = 0; vt < 8; ++vt) {
        const bf16x8 b0 = *(const LAS bf16x8*)(VT + (16 * vt + fr) * 72 + 8 * fq), b1 = *(const LAS bf16x8*)(VT + (16 * vt + fr) * 72 + 32 + 8 * fq);
        f32x4 acc = (f32x4){0.f, 0.f, 0.f, 0.f};
        acc = __builtin_amdgcn_mfma_f32_16x16x32_bf16(a0, b0, acc, 0, 0, 0); acc = __builtin_amdgcn_mfma_f32_16x16x32_bf16(a1, b1, acc, 0, 0, 0);
        u32x2 o; o.x = pk2(acc[0], acc[1]); o.y = pk2(acc[2], acc[3]);
        *(u32x2*)(U + (size_t)(16 * vt + fr) * 128 + 16 * w + 4 * fq) = o;
    }
    __syncthreads();
}
__device__ __forceinline__ void hg_scan(const Ctx& c) {
    const float* dbuf = (const float*)(c.ws + WS_DBUF);
    LAS float* dl = (LAS float*)c.lds;
    for (int p0 = c.bid * 512; p0 < 16 * 8192; p0 += c.G * 512) {
        const int seq = p0 >> 13, b = seq >> 3, h = seq & 7;
        __syncthreads();
        { f32x4 t[8];
#pragma unroll
          for (int i = 0; i < 8; ++i) { const int q = c.tid + 512 * i, ch = q >> 5, k4 = q & 31; t[i] = *(const f32x4*)(dbuf + ((size_t)b * 1024 + ch * 8 + h) * 128 + 4 * k4); }
#pragma unroll
          for (int i = 0; i < 8; ++i) ((LAS f32x4*)dl)[c.tid + 512 * i] = t[i]; }
        __syncthreads();
        const int p = p0 + c.tid, pe = p & 8191, v = pe >> 6, k2 = (pe & 63) * 2;
        float s0 = 0.f, s1 = 0.f;
        const unsigned* __restrict__ Up = (const unsigned*)((unsigned char*)c.out + DO_U); unsigned* __restrict__ Sp = (unsigned*)((unsigned char*)c.out + DO_ST);
        const size_t e0 = ((size_t)b * 1024 + h) * 8192 + (size_t)v * 64 + (k2 >> 1);
        for (int cb0 = 0; cb0 < 128; cb0 += 32) {
            unsigned u[32];
#pragma unroll
            for (int i = 0; i < 32; ++i) u[i] = __builtin_nontemporal_load(&Up[e0 + (size_t)(cb0 + i) * 65536]);
#pragma unroll
            for (int i = 0; i < 32; ++i) { const f32x2 d = *(const LAS f32x2*)(dl + (cb0 + i) * 128 + k2);
                Sp[e0 + (size_t)(cb0 + i) * 65536] = cvt_pk_bf16(s0, s1); s0 = d[0] * s0 + bflo(u[i]); s1 = d[1] * s1 + bfhi(u[i]); }
        }
        float* o = c.out + O_HGP + (size_t)seq * 16384; o[(size_t)k2 * 128 + v] = s0; o[(size_t)(k2 + 1) * 128 + v] = s1;
    }
    __syncthreads();
    for (int p = c.bid * 512 + c.tid; p < 128 * 16384; p += c.G * 512) {
        const int seq = p >> 14, e = p & 16383, k = e >> 7, v = e & 127; const int it = 2048 + seq;
        const float s = c.in[6][p]; const float d = dbuf[(size_t)it * 128 + k]; const float u = bf2f(((const bf16_t*)(c.ws + WS_US))[(size_t)seq * 16384 + v * 128 + k]);
        c.out[O_HGS + p] = d * s + u;
    }
}
__device__ __forceinline__ void hg_pass3(const Ctx& c, int it) {
    const HgItem I = hg_decode(it);
    LAS bf16_t* Q0 = (LAS bf16_t*)c.lds;
    LAS bf16_t* QE = (LAS bf16_t*)(c.lds + 17408);
    LAS bf16_t* KE = (LAS bf16_t*)(c.lds + 34816);
    LAS bf16_t* VT = (LAS bf16_t*)(c.lds + 52224);
    LAS bf16_t* AM = (LAS bf16_t*)(c.lds + 70656);
    LAS bf16_t* STl = (LAS bf16_t*)(c.lds + 79872);
    LAS float* psum = (LAS float*)(c.lds + 114688);
    LAS float* red = (LAS float*)(c.lds + 116736);
    float g[16], kk[16], boff, btot;
    int tid = c.tid; asm volatile("" : "+v"(tid));
    unsigned vw[8]; hg_vt_fetch(c, tid, I, vw);
    u32x4 stv[4]; { const u32x4* src = (const u32x4*)hg_ST(c, it);
#pragma unroll
      for (int i = 0; i < 4; ++i) stv[i] = src[tid + 512 * i]; }
    unsigned short qraw[16]; { const bf16_t* zq = (const bf16_t*)(c.ws + WS_Z + 3 * ZB); const int q_ = tid >> 7, k_ = tid & 127;
#pragma unroll
      for (int i = 0; i < 16; ++i) { const int t = 16 * q_ + i; const int tr = t < I.len ? t : 0; qraw[i] = zq[(size_t)(I.row0 + tr) * ZW + I.h * 128 + k_]; } }
    hg_gates(c, tid, I, psum, g, kk, boff, btot);
    const int q = tid >> 7, k = tid & 127;
    {
      const float p0 = psum[k], p1 = psum[128 + k]; const float ref = I.len == 64 ? p0 + p1 : p0;
      float bc = boff;
#pragma unroll
      for (int i = 0; i < 16; ++i) { const int t = 16 * q + i; bc += g[i]; const bool ok = t < I.len;
          float qv = bf2f(qraw[i]); qv = ok ? qv : 0.f;
          Q0[t * 136 + k] = (bf16_t)f2bf(qv * __expf(bc)); QE[t * 136 + k] = (bf16_t)f2bf(qv * __expf(bc - ref)); KE[t * 136 + k] = (bf16_t)f2bf(kk[i] * __expf(ref - bc)); } }
    hg_vt_store(tid, VT, vw);
    {
#pragma unroll
      for (int i = 0; i < 4; ++i) { const int ci = tid + 512 * i; const int v = ci >> 4, kc = ci & 15; *(LAS u32x4*)(STl + v * 136 + 8 * kc) = stv[i]; } }
    __syncthreads();
    const int fr = tid & 15, fq = (tid >> 4) & 3, w = c.wave;
    { const int tt = w >> 1;
#pragma unroll
      for (int si = 0; si < 2; ++si) { const int st = 2 * (w & 1) + si; f32x4 acc = (f32x4){0.f, 0.f, 0.f, 0.f};
          if (st <= tt) {
#pragma unroll
              for (int ks = 0; ks < 4; ++ks) { const bf16x8 a = *(const LAS bf16x8*)(QE + (16 * tt + fr) * 136 + 32 * ks + 8 * fq), b = *(const LAS bf16x8*)(KE + (16 * st + fr) * 136 + 32 * ks + 8 * fq);
                  acc = __builtin_amdgcn_mfma_f32_16x16x32_bf16(a, b, acc, 0, 0, 0); } }
#pragma unroll
          for (int j = 0; j < 4; ++j) { const int t = 16 * tt + 4 * fq + j, s = 16 * st + fr; AM[t * 72 + s] = (bf16_t)f2bf(s <= t ? acc[j] : 0.f); } } }
    __syncthreads();
    const int tt = w & 3, vh = w >> 2;
    bf16x8 bq[4], ba_[2];
#pragma unroll
    for (int ks = 0; ks < 4; ++ks) bq[ks] = *(const LAS bf16x8*)(Q0 + (16 * tt + fr) * 136 + 32 * ks + 8 * fq);
#pragma unroll
    for (int ks = 0; ks < 2; ++ks) ba_[ks] = *(const LAS bf16x8*)(AM + (16 * tt + fr) * 72 + 32 * ks + 8 * fq);
    f32x4 o[4]; float ss = 0.f;
#pragma unroll
    for (int vi = 0; vi < 4; ++vi) { const int vt = 4 * vh + vi; o[vi] = (f32x4){0.f, 0.f, 0.f, 0.f};
#pragma unroll
        for (int ks = 0; ks < 4; ++ks) { const bf16x8 a = *(const LAS bf16x8*)(STl + (16 * vt + fr) * 136 + 32 * ks + 8 * fq); o[vi] = __builtin_amdgcn_mfma_f32_16x16x32_bf16(a, bq[ks], o[vi], 0, 0, 0); }
#pragma unroll
        for (int ks = 0; ks < 2; ++ks) { const bf16x8 a = *(const LAS bf16x8*)(VT + (16 * vt + fr) * 72 + 32 * ks + 8 * fq); o[vi] = __builtin_amdgcn_mfma_f32_16x16x32_bf16(a, ba_[ks], o[vi], 0, 0, 0); }
        ss += (o[vi][0] * o[vi][0] + o[vi][1] * o[vi][1]) + (o[vi][2] * o[vi][2] + o[vi][3] * o[vi][3]); }
    ss += __shfl_xor(ss, 16); ss += __shfl_xor(ss, 32);
    if (fq == 0) red[vh * 64 + 16 * tt + fr] = ss;
    __syncthreads();
    const int t = 16 * tt + fr;
    if (t < I.len) { const float rs = rsqrtf((red[t] + red[64 + t]) * (1.f / 128.f) + EPS);
        bf16_t* yb = (bf16_t*)(c.ws + WS_Z + 0 * ZB) + (size_t)(I.row0 + t) * ZW + I.h * 128;
#pragma unroll
        for (int vi = 0; vi < 4; ++vi) { const int v0 = 16 * (4 * vh + vi) + 4 * fq; const u32x2 og = *(const u32x2*)(yb + v0); const f32x4 gn = *(const f32x4*)(c.in[19] + v0);
            u32x2 wv; wv.x = pk2(o[vi][0] * rs * gn[0] * sigm(bflo(og.x)), o[vi][1] * rs * gn[1] * sigm(bfhi(og.x))); wv.y = pk2(o[vi][2] * rs * gn[2] * sigm(bflo(og.y)), o[vi][3] * rs * gn[3] * sigm(bfhi(og.y)));
            *(u32x2*)(yb + v0) = wv; } }
    __syncthreads();
}

__device__ __forceinline__ float load_pre_row(const Ctx& c, int m, const bf16_t* Y, const float* slab, int nsl, f32x4 (&y)[8]) {
    float s = 0.f;
    if (m < MP) { const u32x2* yp = (const u32x2*)(Y + (size_t)m * D) + c.lane;
#pragma unroll
        for (int j = 0; j < 8; ++j) { const u32x2 w = __builtin_nontemporal_load(&yp[64 * j]); y[j] = (f32x4){bflo(w.x), bfhi(w.x), bflo(w.y), bfhi(w.y)}; } }
    else {
#pragma unroll
        for (int j = 0; j < 8; ++j) y[j] = (f32x4){0.f, 0.f, 0.f, 0.f};
        for (int sl = 0; sl < nsl; ++sl) { const f32x4* sp = (const f32x4*)(slab + ((size_t)sl * 512 + (m - MP)) * D) + c.lane;
#pragma unroll
            for (int j = 0; j < 8; ++j) y[j] += __builtin_nontemporal_load(&sp[64 * j]); } }
#pragma unroll
    for (int j = 0; j < 8; ++j) s += (y[j][0] * y[j][0] + y[j][1] * y[j][1]) + (y[j][2] * y[j][2] + y[j][3] * y[j][3]);
    return wave_sum(s);
}
__device__ __forceinline__ void phase_norm_mid(const Ctx& c) {
    const int gw = c.bid * 8 + c.wave, NGW = c.G * 8;
    for (int m = gw; m < M; m += NGW) {
        f32x4 y[8]; const float rs = rsqrtf(load_pre_row(c, m, (const bf16_t*)(c.ws + WS_YPRE), (const float*)(c.ws + WS_SLAB6), 8, y) * (1.f / D) + EPS);
        const f32x4* xr = (const f32x4*)xrow_ptr(c, m) + c.lane; float s2 = 0.f;
        u32x2* xf = (u32x2*)((bf16_t*)(c.ws + WS_XF) + (size_t)m * D) + c.lane;
#pragma unroll
        for (int j = 0; j < 8; ++j) { const f32x4 x = __builtin_nontemporal_load(&xr[64 * j]); const f32x4 g = ((const f32x4*)c.in[25])[c.lane + 64 * j];
            y[j] = x + y[j] * rs * g; s2 += (y[j][0] * y[j][0] + y[j][1] * y[j][1]) + (y[j][2] * y[j][2] + y[j][3] * y[j][3]);
            u32x2 w; w.x = cvt_pk_bf16(y[j][0], y[j][1]); w.y = cvt_pk_bf16(y[j][2], y[j][3]); xf[64 * j] = w; }
        const float r2 = rsqrtf(wave_sum(s2) * (1.f / D) + EPS);
        if (c.lane == 0) ((float*)(c.ws + WS_R2))[m] = r2;
    }
}
__device__ __forceinline__ void phase_norm_fin(const Ctx& c) {
    const int gw = c.bid * 8 + c.wave, NGW = c.G * 8;
    for (int m = gw; m < M; m += NGW) {
        f32x4 y[8]; const float rs = rsqrtf(load_pre_row(c, m, (const bf16_t*)(c.ws + WS_YPRE2), (const float*)(c.ws + WS_SLAB9), 11, y) * (1.f / D) + EPS);
        f32x4* o = (f32x4*)(c.out + (size_t)m * D) + c.lane; const u32x2* x1 = (const u32x2*)((const bf16_t*)(c.ws + WS_XF) + (size_t)m * D) + c.lane;
#pragma unroll
        for (int j = 0; j < 8; ++j) { const f32x4 g = ((const f32x4*)c.in[31])[c.lane + 64 * j]; const u32x2 w = __builtin_nontemporal_load(&x1[64 * j]);
            __builtin_nontemporal_store((f32x4){bflo(w.x), bfhi(w.x), bflo(w.y), bfhi(w.y)} + y[j] * rs * g, &o[64 * j]); }
    }
}

#define XB_TMO      128
#define XB_XCNT(j)  (256  + 64 * (j))
#define XB_XSUB(j)  (1280 + 64 * (j))
#define XB_XGEN(j)  (2304 + 64 * (j))
#define XB_TOP      3328
#define XB_TOPGEN   3392
#define XCD_BAR_WORDS 3456
#define XB_SPIN_CAP (1u << 20)
__device__ __forceinline__ unsigned xb_ld(unsigned* p)              { return __hip_atomic_load(p, __ATOMIC_RELAXED, __HIP_MEMORY_SCOPE_AGENT); }
__device__ __forceinline__ unsigned xb_add(unsigned* p, unsigned v) { return __hip_atomic_fetch_add(p, v, __ATOMIC_RELAXED, __HIP_MEMORY_SCOPE_AGENT); }
__device__ __forceinline__ unsigned xb_xcc_id() { return (unsigned)__builtin_amdgcn_s_getreg((3 << 11) | 20) & 0xFu; }
#define XB_SPIN(cond, bar) do { unsigned _sp = 0; while (cond) { __builtin_amdgcn_s_sleep(1); \
    if ((++_sp & 255u) == 0u) { if (xb_ld(&(bar)[XB_TMO])) break; if (_sp > XB_SPIN_CAP) { atomicAdd(&(bar)[XB_TMO], 1u); break; } } } } while (0)
struct XcdBarrier { unsigned* bar; unsigned x; volatile LAS unsigned* st; };
__device__ __forceinline__ XcdBarrier xcd_barrier_post(unsigned* bar, volatile LAS unsigned* st) {
    XcdBarrier b; b.bar = bar; b.x = xb_xcc_id(); b.st = st;
    if (threadIdx.x == 0) (void)xb_add(&bar[XB_XCNT(b.x)], 1u);
    return b;
}
__device__ __forceinline__ void xcd_barrier_complete(unsigned* bar, unsigned x, unsigned& nloc, unsigned& nx) {
    const unsigned G = gridDim.x * gridDim.y * gridDim.z;
    unsigned sum, cnt, mine, sp = 0u;
    for (;;) {
        sum = 0u; cnt = 0u; mine = 0u;
#pragma unroll
        for (unsigned j = 0; j < 16; ++j) { const unsigned c = xb_ld(&bar[XB_XCNT(j)]); sum += c; cnt += (c > 0u) ? 1u : 0u; mine = (j == x) ? c : mine; }
        if (sum == G) break;
        __builtin_amdgcn_s_sleep(1);
        if ((++sp & 255u) == 0u) { if (xb_ld(&bar[XB_TMO])) break; if (sp > XB_SPIN_CAP) { atomicAdd(&bar[XB_TMO], 1u); break; } }
    }
    nloc = mine > 0u ? mine : 1u; nx = cnt > 0u ? cnt : 1u;
}
__device__ __forceinline__ void xcd_barrier(const XcdBarrier& b) {
    asm volatile("s_waitcnt vmcnt(0)" ::: "memory");
    __syncthreads();
    if (threadIdx.x == 0) {
        unsigned* bar = b.bar;
        __builtin_amdgcn_s_waitcnt(0);
        unsigned nloc = b.st[0], nx = b.st[1];
        if (nloc == 0u) { xcd_barrier_complete(bar, b.x, nloc, nx); b.st[0] = nloc; b.st[1] = nx; }
        const unsigned old = xb_add(&bar[XB_XSUB(b.x)], 1u);
        const unsigned gen = old / nloc;
        if (old + 1u == (gen + 1u) * nloc) {
            __builtin_amdgcn_fence(__ATOMIC_RELEASE, "agent");
            asm volatile("s_waitcnt vmcnt(0)" ::: "memory");
            const unsigned og = xb_add(&bar[XB_TOP], 1u);
            const unsigned tg = og / nx;
            if (og + 1u == (tg + 1u) * nx) xb_add(&bar[XB_TOPGEN], 1u);
            else XB_SPIN(xb_ld(&bar[XB_TOPGEN]) == tg, bar);
            __builtin_amdgcn_fence(__ATOMIC_ACQUIRE, "agent");
            xb_add(&bar[XB_XGEN(b.x)], 1u);
            asm volatile("s_waitcnt vmcnt(0)" ::: "memory");
        } else {
            XB_SPIN(xb_ld(&bar[XB_XGEN(b.x)]) == gen, bar);
            __builtin_amdgcn_fence(__ATOMIC_ACQUIRE, "agent");
            asm volatile("s_waitcnt vmcnt(0)" ::: "memory");
        }
    }
    __syncthreads();
}

struct Args { const float* in[32]; float* out; unsigned char* ws; int ph_lo, ph_hi, rep, pad; };

__global__ void __launch_bounds__(512, 2) fwd_kernel(Args args) {
    extern __shared__ __attribute__((aligned(16))) unsigned char lds_raw[];
    Ctx c; c.lds = (LAS unsigned char*)lds_raw; c.tid = threadIdx.x; c.lane = c.tid & 63; c.wave = __builtin_amdgcn_readfirstlane(c.tid >> 6); c.G = gridDim.x; c.bid = blockIdx.x;
    c.in = args.in; c.out = args.out; c.ws = args.ws;
    const int lo = args.ph_lo, hi = args.ph_hi;
#define REP(bit) for (int r_ = 0, n_ = 1 + ((args.rep >> (bit)) & 1); r_ < n_; ++r_)
    const int gw = c.bid * 8 + c.wave, NGW = c.G * 8;
    bf16_t* Z = (bf16_t*)(c.ws + WS_Z);
#ifndef PHMASK
#define PHMASK 0x7ff
#endif
#define IN(k) (((PHMASK >> (k)) & 1) && lo <= (k) && (k) < hi)
#define SEAM(k) do { if (IN(k) && IN((k) + 1)) { xcd_barrier(bar); } } while (0)
    volatile LAS unsigned* misc = (volatile LAS unsigned*)(c.lds + 131072);
    if (c.tid < 8) misc[c.tid] = 0u;
    __syncthreads();
    XcdBarrier bar = xcd_barrier_post((unsigned*)c.ws, misc);
    if (lo < 0) cg::this_grid().sync();

    if (IN(0)) { REP(0) phase_prep(c); }
    SEAM(0);
    if (IN(1)) {
        { OpPlain op{(const bf16_t*)((unsigned char*)c.out + DO_XN), (const bf16_t*)((unsigned char*)c.out + DO_WIN), 2048, 2048, 2048}; Order S; S.init(M / 256, 48, c.G, c.bid, 1, WGM_P1);
          EpiZ E{Z}; pg8::gemm_phase<EpiZ, OpPlain>(c.lds, op, S, E); }
        __syncthreads();
        if (c.G == 256 && c.bid >= 96 && c.bid < c.G - 16) prep_late(c, (c.bid - 96) * 8 + c.wave, 144 * 8);
        else if (c.G != 256) prep_late(c, c.bid * 8 + c.wave, c.G * 8);
        if (c.bid >= c.G - 16) {
          OpPlain op{(const bf16_t*)(c.ws + WS_MEMN), (const bf16_t*)(c.ws + WS_WKV), 2048, 2048, 2048}; Order S; S.init(2, 8, 16, c.bid - (c.G - 16));
          EpiKV E{c.out, (bf16_t*)(c.ws + WS_KBP)}; pg8::gemm_phase<EpiKV, OpPlain>(c.lds, op, S, E); }
    }
    SEAM(1);
    if (IN(2)) {
#if !defined(P2SEL) || P2SEL==0
        { OpAttn op{Z + 1 * (size_t)M * ZW, (const bf16_t*)(c.ws + WS_KBP), (const bf16_t*)(c.ws + WS_KBS), 256, 1024, 1024, 0}; Order S; S.init(320, 1, c.G, c.bid);
          EpiS E{(bf16_t*)(c.ws + WS_P), (float*)(c.ws + WS_RS)}; pg8::gemm_phase<EpiS, OpAttn>(c.lds, op, S, E); }
#endif
        __syncthreads();
        { LAS float* scr = (LAS float*)(c.lds + c.wave * 16384);
          for (int r = gw - 64 * 8; r >= 0 && r < 2 * 128; r += NGW) { const int b = r >> 7; transpose_job(c.out + O_MV + (size_t)b * 262144, 256, 1024, (bf16_t*)(c.ws + WS_VTP) + (size_t)b * 262144, 256, r & 127, scr, c.lane, [](int n0) { return n0; }); } }
        __syncthreads();
#if !defined(P2SEL) || P2SEL==1
        REP(1) for (int it = c.G - 1 - c.bid; it < 2176; it += c.G) hg_pass1(c, it);
#endif
        __syncthreads();
#if !defined(P2SEL) || P2SEL==2
        REP(2) for (int r = gw; r < 256 * 16; r += NGW) lru_item(c, r >> 4, r & 15, 0, c.lds + c.wave * 9728);
#endif
    }
    SEAM(2);
    if (IN(3)) {
        { OpAttn op{(const bf16_t*)(c.ws + WS_P), (const bf16_t*)(c.ws + WS_VTP), (const bf16_t*)(c.ws + WS_VTS), 256, 1024, 256, 1}; Order S; S.init(320, 1, c.G, c.bid);
          EpiPV E{Z + 1 * (size_t)M * ZW, (const float*)(c.ws + WS_RS)}; pg8::gemm_phase<EpiPV, OpAttn>(c.lds, op, S, E); }
        __syncthreads();
        for (int p = (c.G - 1 - c.bid) * 512 + c.tid; p < 2048; p += c.G * 512) { const int b = p >> 10, ch = p & 1023; float h = 0.f;
            const float* A = (const float*)(c.ws + WS_AGGA); const float* B = (const float*)(c.ws + WS_AGGB); float* H = (float*)(c.ws + WS_HIN);
            for (int k0 = 0; k0 < 128; k0 += 16) { float av[16], bv[16];
#pragma unroll
                for (int i = 0; i < 16; ++i) { const size_t e = (size_t)(b * 128 + k0 + i) * 1024 + ch; av[i] = A[e]; bv[i] = B[e]; }
#pragma unroll
                for (int i = 0; i < 16; ++i) { const size_t e = (size_t)(b * 128 + k0 + i) * 1024 + ch; H[e] = h; h = av[i] * h + bv[i]; } } }
        REP(3) hg_scan(c);
    }
    SEAM(3);
    if (IN(4)) {
        for (int it = c.bid; it < 2176; it += c.G) hg_pass3(c, it);
        __syncthreads();
        for (int r = NGW - 1 - gw; r < 272 * 16; r += NGW) lru_item(c, r >> 4, r & 15, 1, c.lds + c.wave * 9728);
    }
    SEAM(4);
    if (IN(5)) {
        const bool conv_first = (c.bid & 1) != 0; const bool full = c.G == 256;
        for (int pass = 0; pass < 2; ++pass) {
            if ((pass == 0) == conv_first) {
                if (!full || c.bid >= 48) {
                  LAS float* scr = (LAS float*)(c.lds + c.wave * 16384); constexpr int I_UP = 32 * 352, I_DN = 88 * 64;
                  const int w0 = full ? (c.bid - 48) * 8 + c.wave : c.bid * 8 + c.wave, nw = full ? (c.G - 48) * 8 : c.G * 8;
                  for (int it = w0; it < (full ? I_UP : I_UP + I_DN); it += nw) {
                      if (it < I_UP) transpose_job(c.in[27], 2048, 11264, (bf16_t*)(c.ws + WS_WUP), 2048, it, scr, c.lane, [](int n0) { const int isv = n0 >= FF, n = isv ? n0 - FF : n0; return (n >> 7) * 256 + isv * 128 + (n & 127); }, c.in[26]);
                      else transpose_job(c.in[30], FF, 2048, (bf16_t*)(c.ws + WS_WDN), FF, it - I_UP, scr, c.lane, [](int n0) { return n0; }); } }
            } else {
                OpMerge op{(const bf16_t*)(c.ws + WS_P), Z + 0 * (size_t)M * ZW, Z + 1 * (size_t)M * ZW, (const bf16_t*)(c.ws + WS_WBR), 1024, 1024, 1024}; pg8::MergeOrder S; S.init(M / 256, 8, c.G, c.bid, pg8::WGM);
                EpiMerge E{Z + 6 * (size_t)M * ZW, c.in[23], (bf16_t*)(c.ws + WS_MM), (unsigned*)c.ws + 4096}; pg8::gemm_phase<EpiMerge, OpMerge, pg8::MergeOrder>(c.lds, op, S, E);
            }
            __syncthreads();
        }
    }
    SEAM(5);
    if (IN(6)) {
        { OpPlain op{(const bf16_t*)(c.ws + WS_MM), (const bf16_t*)(c.ws + WS_WOUT), 2048, 2048, 2048}; Order S; S.init(MP / 256, 8, c.G, c.bid);
          EpiPre E{(bf16_t*)(c.ws + WS_YPRE)}; pg8::gemm_phase<EpiPre, OpPlain>(c.lds, op, S, E); }
        __syncthreads();
        { OpSplit op{(const bf16_t*)(c.ws + WS_MM), (const bf16_t*)(c.ws + WS_WOUT), 256, 2048, 2048}; Order S; S.init(2 * 8, 8, c.G, c.bid);
          EpiSlab E{(float*)(c.ws + WS_SLAB6)}; pg8::gemm_phase<EpiSlab, OpSplit>(c.lds, op, S, E); }
    }
    SEAM(6);
    if (IN(7)) { REP(7) phase_norm_mid(c); }
    SEAM(7);
    if (IN(8)) {
        OpUp op{(const bf16_t*)(c.ws + WS_XF), (const bf16_t*)(c.ws + WS_WUP), 2048, 2048, 2048}; Order S; S.init(68, 44, c.G, c.bid, 1, WGM_P8);
        EpiUp E{(bf16_t*)(c.ws + WS_ACT), c.in[28], c.in[29], c.in[7], c.out, (const float*)(c.ws + WS_R2)}; pg8::gemm_phase<EpiUp, OpUp>(c.lds, op, S, E);
        __syncthreads();
        if (c.G == 256 && c.bid >= 176) {
          LAS float* scr = (LAS float*)(c.lds + c.wave * 16384); constexpr int I_DN = 88 * 64;
          for (int it = (c.bid - 176) * 8 + c.wave; it < I_DN; it += 80 * 8) transpose_job(c.in[30], FF, 2048, (bf16_t*)(c.ws + WS_WDN), FF, it, scr, c.lane, [](int n0) { return n0; }); }
    }
    SEAM(8);
    if (IN(9)) {
        { OpPlain op{(const bf16_t*)(c.ws + WS_ACT), (const bf16_t*)(c.ws + WS_WDN), FF, FF, FF}; Order S; S.init(MP / 256, 8, c.G, c.bid);
          EpiPre E{(bf16_t*)(c.ws + WS_YPRE2)}; pg8::gemm_phase<EpiPre, OpPlain>(c.lds, op, S, E); }
        __syncthreads();
        { OpSplit op{(const bf16_t*)(c.ws + WS_ACT), (const bf16_t*)(c.ws + WS_WDN), 512, FF, FF}; Order S; S.init(2 * 11, 8, c.G, c.bid);
          EpiSlab E{(float*)(c.ws + WS_SLAB9)}; pg8::gemm_phase<EpiSlab, OpSplit>(c.lds, op, S, E); }
    }
    SEAM(9);
    if (IN(10)) { phase_norm_fin(c); }
#undef IN
#undef SEAM
}

extern "C" void kernel_launch(void* const* d_in, const int* in_sizes, int n_in, void* d_out, int out_size, void* d_ws, size_t ws_size, hipStream_t stream) {
    static int grid = 0;
    if (grid == 0) {
        if (n_in != 32 || (size_t)out_size != O_END || ws_size < WS_END) { fprintf(stderr, "kernel_launch: unexpected shapes (n_in %d out %d ws %zu)\n", n_in, out_size, ws_size); grid = -1; return; }
        int dev = 0, cus = 0, per_cu = 0;
        hipGetDevice(&dev); hipDeviceGetAttribute(&cus, hipDeviceAttributeMultiprocessorCount, dev);
        hipFuncSetAttribute((const void*)fwd_kernel, hipFuncAttributeMaxDynamicSharedMemorySize, LDS_BYTES);
        hipOccupancyMaxActiveBlocksPerMultiprocessor(&per_cu, (const void*)fwd_kernel, 512, LDS_BYTES);
        if (per_cu < 1) per_cu = 1;
        grid = cus * 1;
        (void)hipGetLastError();
    }
    if (grid < 0) return;
    if (hipMemsetAsync(d_ws, 0, 32768, stream) != hipSuccess) { fprintf(stderr, "memset failed\n"); return; }
    Args a{};
    for (int i = 0; i < 32; ++i) a.in[i] = (const float*)d_in[i];
    a.out = (float*)d_out; a.ws = (unsigned char*)d_ws;
#if MK_LAUNCHES == 1
    a.ph_lo = 0; a.ph_hi = NPH;
    void* kargs[] = {&a};
    hipError_t e = hipLaunchCooperativeKernel((const void*)fwd_kernel, dim3(grid), dim3(512), kargs, LDS_BYTES, stream);
    if (e != hipSuccess) fprintf(stderr, "cooperative launch failed: %s (grid %d)\n", hipGetErrorString(e), grid);
#else
#ifdef REPMASK
    a.rep = REPMASK;
#endif
    for (int p = 0; p < NPH; ++p) { a.ph_lo = p; a.ph_hi = p + 1; hipLaunchKernelGGL(fwd_kernel, dim3(grid), dim3(512), LDS_BYTES, stream, a);
#ifdef DUPMASK
        if ((DUPMASK >> p) & 1) hipLaunchKernelGGL(fwd_kernel, dim3(grid), dim3(512), LDS_BYTES, stream, a);
#endif
    }
#endif
}
```
